# Optimizing an MI355X kernel written in HIP

```python
import jax, jax.numpy as jnp
from jax import lax
import numpy as np

D_MODEL = 1024
BATCH = 1
SEQ = 16384
DEPTH = 1

CHUNK = 64
EPS = 1e-6

GDN_HEADS = 8
GDN_DK = 64
GDN_DV = 64
CONV_K = 4
GDN_QK = GDN_HEADS * GDN_DK
GDN_V = GDN_HEADS * GDN_DV
GDN_CONV_W = 2 * GDN_QK + GDN_V

FOX_HEADS = 8
FOX_DH = 64
FOX_W = FOX_HEADS * FOX_DH
Q_BLOCK = 128

N_BRANCH = 2
SPLIT_SIZES = (GDN_CONV_W, GDN_V, GDN_HEADS, GDN_HEADS,
               FOX_W, FOX_W, FOX_W, FOX_W, FOX_HEADS,
               N_BRANCH * D_MODEL)
D_IN = sum(SPLIT_SIZES)

kernel_name = "hybrid_gdn_fox_gated_merge"


def rmsnorm(x, w):
    xf = x.astype(jnp.float32)
    y = xf * lax.rsqrt(jnp.mean(xf * xf, axis=-1, keepdims=True) + EPS)
    return (y * w.astype(jnp.float32)).astype(x.dtype)


def l2norm(x):
    return x * lax.rsqrt(jnp.sum(x * x, axis=-1, keepdims=True) + EPS)


def causal_depthwise_conv(x, w):
    c = x.shape[-1]
    return lax.conv_general_dilated(
        x, w[:, None, :].astype(x.dtype), window_strides=(1,),
        padding=[(CONV_K - 1, 0)], dimension_numbers=('NWC', 'WIO', 'NWC'),
        feature_group_count=c)


def gated_deltanet(qkv, z, b_logit, a_logit, conv_w, a_log, dt_bias, norm_w):
    B, S, _ = qkv.shape
    H, C = GDN_HEADS, CHUNK
    n = S // C
    dtype = qkv.dtype
    qkv = jax.nn.silu(causal_depthwise_conv(qkv, conv_w)).astype(jnp.float32)
    q, k, v = jnp.split(qkv, [GDN_QK, 2 * GDN_QK], axis=-1)
    q = l2norm(q.reshape(B, S, H, GDN_DK)) * (GDN_DK ** -0.5)
    k = l2norm(k.reshape(B, S, H, GDN_DK))
    v = v.reshape(B, S, H, GDN_DV)
    beta = jax.nn.sigmoid(b_logit.astype(jnp.float32))
    g = -jnp.exp(a_log.astype(jnp.float32)) * jax.nn.softplus(
        a_logit.astype(jnp.float32) + dt_bias.astype(jnp.float32))

    def chunkify(t):
        return t.reshape(B, n, C, H, -1).transpose(0, 3, 1, 2, 4)

    q, k, v = chunkify(q), chunkify(k), chunkify(v)
    beta = beta.reshape(B, n, C, H).transpose(0, 3, 1, 2)
    g = jnp.cumsum(g.reshape(B, n, C, H).transpose(0, 3, 1, 2), axis=-1)

    causal = jnp.tril(jnp.ones((C, C), dtype=bool))
    strict = jnp.tril(jnp.ones((C, C), dtype=bool), -1)
    diff = g[..., :, None] - g[..., None, :]
    decay = jnp.exp(jnp.where(causal, diff, -jnp.inf))

    kb = k * beta[..., None]
    vb = v * beta[..., None]
    m_low = jnp.where(strict, jnp.einsum('bhnid,bhnjd->bhnij', kb, k) * decay, 0.0)
    eye = jnp.eye(C, dtype=jnp.float32)
    t_inv = lax.linalg.triangular_solve(
        m_low + eye, jnp.broadcast_to(eye, m_low.shape),
        left_side=True, lower=True, unit_diagonal=True)
    w_val = jnp.einsum('bhnij,bhnjd->bhnid', t_inv, vb)
    k_cum = jnp.einsum('bhnij,bhnjd->bhnid', t_inv, kb * jnp.exp(g)[..., None])
    a_qk = jnp.einsum('bhnid,bhnjd->bhnij', q, k) * decay
    q_g = q * jnp.exp(g)[..., None]
    k_tail = k * jnp.exp(g[..., -1:] - g)[..., None]
    g_last = jnp.exp(g[..., -1])

    def step(state, xs):
        w_c, kc_c, qg_c, a_c, kt_c, gl_c = xs
        u = w_c - jnp.einsum('bhcd,bhde->bhce', kc_c, state)
        o = jnp.einsum('bhcd,bhde->bhce', qg_c, state) + jnp.einsum('bhij,bhje->bhie', a_c, u)
        state = state * gl_c[..., None, None] + jnp.einsum('bhcd,bhce->bhde', kt_c, u)
        return state, o

    mv = lambda t: jnp.moveaxis(t, 2, 0)
    state0 = jnp.zeros((B, H, GDN_DK, GDN_DV), jnp.float32)
    _, o = lax.scan(step, state0, (mv(w_val), mv(k_cum), mv(q_g), mv(a_qk), mv(k_tail), mv(g_last)))
    o = o.transpose(1, 0, 3, 2, 4).reshape(B, S, H, GDN_DV)
    zh = z.reshape(B, S, H, GDN_DV).astype(jnp.float32)
    y = rmsnorm(o, norm_w) * jax.nn.silu(zh)
    return y.reshape(B, S, GDN_V).astype(dtype)


def forgetting_attention(q, k, v, z, f_logit, f_bias, qn_w, kn_w, on_w):
    B, S, _ = q.shape
    H, dh = FOX_HEADS, FOX_DH
    nb = S // Q_BLOCK
    dtype = q.dtype
    qh = rmsnorm(q.reshape(B, S, H, dh), qn_w).transpose(0, 2, 1, 3)
    kh = rmsnorm(k.reshape(B, S, H, dh), kn_w).transpose(0, 2, 1, 3)
    vh = v.reshape(B, S, H, dh).transpose(0, 2, 1, 3)
    log_f = jax.nn.log_sigmoid(f_logit.astype(jnp.float32) + f_bias.astype(jnp.float32))
    c = lax.cumsum(log_f, axis=1).transpose(0, 2, 1)
    q_blocks = qh.reshape(B, H, nb, Q_BLOCK, dh).transpose(2, 0, 1, 3, 4)
    c_blocks = c.reshape(B, H, nb, Q_BLOCK).transpose(2, 0, 1, 3)
    key_pos = jnp.arange(S)
    scale = dh ** -0.5

    def block(args):
        qb, cb, i = args
        q_pos = i * Q_BLOCK + jnp.arange(Q_BLOCK)
        s = jnp.einsum('bhqd,bhkd->bhqk', qb, kh).astype(jnp.float32) * scale
        s = s + cb[..., :, None] - c[..., None, :]
        s = jnp.where(key_pos[None, :] <= q_pos[:, None], s, -jnp.inf)
        p = jax.nn.softmax(s, axis=-1)
        return jnp.einsum('bhqk,bhkd->bhqd', p.astype(vh.dtype), vh)

    o = lax.map(block, (q_blocks, c_blocks, jnp.arange(nb)))
    o = o.transpose(1, 0, 3, 2, 4).reshape(B, S, H, dh)
    zh = z.reshape(B, S, H, dh).astype(jnp.float32)
    y = rmsnorm(o.astype(jnp.float32), on_w) * jax.nn.silu(zh)
    return y.reshape(B, S, FOX_W).astype(dtype)


def setup_inputs(seed: int = 0) -> dict:
    key = jax.random.key(seed)
    ks = jax.random.split(key, 20)
    f32 = jnp.float32
    nrm = lambda k, shape, scale: jax.random.normal(k, shape, f32) * scale
    gain = lambda k, shape: 1.0 + 0.02 * jax.random.normal(k, shape, f32)
    dt = jnp.exp(jax.random.uniform(ks[5], (DEPTH, GDN_HEADS), f32,
                                    math_log(0.001), math_log(0.1)))
    return {
        'x': jax.random.normal(ks[0], (BATCH, SEQ, D_MODEL), f32),
        'norm_w': gain(ks[1], (DEPTH, D_MODEL)),
        'w_in': nrm(ks[2], (DEPTH, D_MODEL, D_IN), D_MODEL ** -0.5),
        'gate_b': nrm(ks[3], (DEPTH, N_BRANCH * D_MODEL), 0.02),
        'conv_w': nrm(ks[4], (DEPTH, CONV_K, GDN_CONV_W), CONV_K ** -0.5),
        'a_log': jnp.log(jax.random.uniform(ks[6], (DEPTH, GDN_HEADS), f32, 1.0, 16.0)),
        'dt_bias': dt + jnp.log(-jnp.expm1(-dt)),
        'gdn_norm_w': gain(ks[7], (DEPTH, GDN_DV)),
        'f_bias': 2.0 + 0.1 * jax.random.normal(ks[8], (DEPTH, FOX_HEADS), f32),
        'fox_qn_w': gain(ks[9], (DEPTH, FOX_DH)),
        'fox_kn_w': gain(ks[10], (DEPTH, FOX_DH)),
        'fox_on_w': gain(ks[11], (DEPTH, FOX_DH)),
        'w_up_gdn': nrm(ks[12], (DEPTH, GDN_V, D_MODEL), GDN_V ** -0.5),
        'w_up_fox': nrm(ks[13], (DEPTH, FOX_W, D_MODEL), FOX_W ** -0.5),
        'w_out': nrm(ks[14], (DEPTH, D_MODEL, D_MODEL), D_MODEL ** -0.5),
        'final_norm_w': gain(ks[15], (D_MODEL,)),
    }


def math_log(v):
    return float(np.log(v))


def reference(x, norm_w, w_in, gate_b, conv_w, a_log, dt_bias, gdn_norm_w, f_bias,
              fox_qn_w, fox_kn_w, fox_on_w, w_up_gdn, w_up_fox, w_out, final_norm_w):
    split_points = [int(s) for s in np.cumsum(SPLIT_SIZES)[:-1]]
    for l in range(DEPTH):
        h = rmsnorm(x, norm_w[l])
        proj = jnp.einsum('bsd,de->bse', h, w_in[l])
        (gdn_qkv, gdn_z, gdn_b, gdn_a, fox_q, fox_k, fox_v, fox_z, fox_f,
         gate_logit) = jnp.split(proj, split_points, axis=-1)
        y_a = gated_deltanet(gdn_qkv, gdn_z, gdn_b, gdn_a, conv_w[l], a_log[l],
                             dt_bias[l], gdn_norm_w[l])
        y_b = forgetting_attention(fox_q, fox_k, fox_v, fox_z, fox_f, f_bias[l],
                                   fox_qn_w[l], fox_kn_w[l], fox_on_w[l])
        gates = jax.nn.sigmoid(gate_logit + gate_b[l])
        g_a, g_b = jnp.split(gates, 2, axis=-1)
        merged = (g_a * jnp.einsum('bsc,cd->bsd', y_a, w_up_gdn[l])
                  + g_b * jnp.einsum('bsc,cd->bsd', y_b, w_up_fox[l]))
        x = x + jnp.einsum('bsd,de->bse', merged, w_out[l])
    return rmsnorm(x, final_norm_w)
```

```cpp
#include <hip/hip_runtime.h>
#include <hip/hip_cooperative_groups.h>
#include <cstdio>
#include <cstdint>
namespace cg = cooperative_groups;

#define DI __device__ __forceinline__
namespace pg8 {
#define PG8_LAS __attribute__((address_space(3)))
typedef unsigned short bf16_t;
typedef short bf16x8 __attribute__((ext_vector_type(8)));
typedef float f32x4 __attribute__((ext_vector_type(4)));
typedef unsigned u32x4 __attribute__((ext_vector_type(4)));
constexpr int BM = 256, BK = 64, HALF = 128, HTB = HALF * BK * 2, STAGE_BYTES = 8 * HTB, NXCD = 8, WGM = 8;

__host__ __device__ __forceinline__ int lds_byte(int r, int c) { const int st = (r >> 4) * 2 + (c >> 5), rr = r & 15, cc = c & 31, ob = rr * 64 + cc * 2; return st * 1024 + (ob ^ (((ob >> 9) & 1) << 5)); }
__host__ __device__ __forceinline__ void stage_rc(int b, int& R, int& C) { const int st = b / 1024, sb = b % 1024, swz = sb ^ (((sb >> 9) & 1) << 5); R = (st >> 1) * 16 + swz / 64; C = (st & 1) * 32 + (swz % 64) / 2; }
__host__ __device__ __forceinline__ int perm32(int rho) { const int n = rho >> 4, i = rho & 15; return 8 * (i >> 2) + 4 * n + (i & 3); }

struct Unit { int pm, pn; };
struct Gemm { const bf16_t* A; const bf16_t* Bt; int M, N, K; };

struct StaticOrder {
    int nM, nN, nwg, G, c;
    __host__ __device__ void init(int M, int N, int G_, int c_) { nM = M / BM; nN = N / BM; nwg = nM * nN; G = G_; c = c_; }
    __host__ __device__ bool next(int i, Unit& u) const {
        const long L = (long)i * G + c; if (L >= nwg) return false;
        int wgid = (int)L; { const int q = nwg / NXCD, r = nwg % NXCD, xcd = wgid % NXCD, off = wgid / NXCD; wgid = (xcd < r ? xcd * (q + 1) : r * (q + 1) + (xcd - r) * q) + off; }
        const int nig = WGM * nN, gid = wgid / nig, fm = gid * WGM, gsz = (nM - fm) < WGM ? (nM - fm) : WGM;
        u.pm = fm + ((wgid % nig) % gsz); u.pn = (wgid % nig) / gsz; return true;
    }
    __device__ __forceinline__ void a_ready(const Unit&) const {}
    __device__ __forceinline__ void done(const Unit&) const {}
};

__device__ __forceinline__ unsigned cvt_pk_bf16(float lo, float hi) { unsigned r; asm volatile("v_cvt_pk_bf16_f32 %0, %1, %2" : "=v"(r) : "v"(lo), "v"(hi)); return r; }
__device__ __forceinline__ float bflo(unsigned u) { return __uint_as_float(u << 16); }
__device__ __forceinline__ float bfhi(unsigned u) { return __uint_as_float(u & 0xffff0000u); }
__device__ __forceinline__ float sigm(float v) { return __builtin_amdgcn_rcpf(1.0f + __expf(-v)); }

struct EpiSplitBf16 {
    static constexpr bool PERM = true, AFTER_DRAIN = false;
    bf16_t* O; size_t split_stride;
    __device__ __forceinline__ void operator()(const f32x4 (&acc)[2][2][4][2], const Unit& u, int wr, int wc, int fr, int fq) const {
        const int row0 = u.pm * BM + wr * 64 + fr; int colt = u.pn * BM; const int t = colt / 512; bf16_t* base = O + (size_t)t * split_stride; colt -= t * 512;
        const int col0 = colt + wc * 32 + 8 * fq;
#pragma unroll
        for (int ai = 0; ai < 2; ++ai)
#pragma unroll
            for (int m = 0; m < 4; ++m) { bf16_t* rowp = base + (size_t)(row0 + ai * HALF + m * 16) * 512 + col0;
#pragma unroll
                for (int bj = 0; bj < 2; ++bj) { const f32x4 v0 = acc[ai][bj][m][0], v1 = acc[ai][bj][m][1];
                    u32x4 w; w.x = cvt_pk_bf16(v0[0], v0[1]); w.y = cvt_pk_bf16(v0[2], v0[3]); w.z = cvt_pk_bf16(v1[0], v1[1]); w.w = cvt_pk_bf16(v1[2], v1[3]);
                    *(u32x4*)(rowp + bj * HALF) = w; } }
    }
};
struct EpiGate {
    static constexpr bool PERM = true, AFTER_DRAIN = false;
    bf16_t* Mo; const bf16_t* G0; size_t split_stride; const float* gb; int accum;
    __device__ __forceinline__ void operator()(const f32x4 (&acc)[2][2][4][2], const Unit& u, int wr, int wc, int fr, int fq) const {
        const int row0 = u.pm * BM + wr * 64 + fr; const int colt = u.pn * BM; const int t = colt / 512;
        const bf16_t* gbase = G0 + (size_t)t * split_stride; const int col0 = colt + wc * 32 + 8 * fq, gcol0 = col0 - t * 512;
#pragma unroll
        for (int bj = 0; bj < 2; ++bj) {
            const f32x4 b0 = *(const f32x4*)(gb + col0 + bj * HALF), b1 = *(const f32x4*)(gb + col0 + bj * HALF + 4);
#pragma unroll
            for (int ai = 0; ai < 2; ++ai)
#pragma unroll
                for (int m = 0; m < 4; ++m) { const size_t row = (size_t)(row0 + ai * HALF + m * 16);
                    const u32x4 g = *(const u32x4*)(gbase + row * 512 + gcol0 + bj * HALF);
                    const f32x4 v0 = acc[ai][bj][m][0], v1 = acc[ai][bj][m][1];
                    float r0 = v0[0] * sigm(bflo(g.x) + b0[0]), r1 = v0[1] * sigm(bfhi(g.x) + b0[1]), r2 = v0[2] * sigm(bflo(g.y) + b0[2]), r3 = v0[3] * sigm(bfhi(g.y) + b0[3]);
                    float r4 = v1[0] * sigm(bflo(g.z) + b1[0]), r5 = v1[1] * sigm(bfhi(g.z) + b1[1]), r6 = v1[2] * sigm(bflo(g.w) + b1[2]), r7 = v1[3] * sigm(bfhi(g.w) + b1[3]);
                    bf16_t* op = Mo + row * 1024 + col0 + bj * HALF;
                    if (accum) { const u32x4 p = *(const u32x4*)op; r0 += bflo(p.x); r1 += bfhi(p.x); r2 += bflo(p.y); r3 += bfhi(p.y); r4 += bflo(p.z); r5 += bfhi(p.z); r6 += bflo(p.w); r7 += bfhi(p.w); }
                    u32x4 w; w.x = cvt_pk_bf16(r0, r1); w.y = cvt_pk_bf16(r2, r3); w.z = cvt_pk_bf16(r4, r5); w.w = cvt_pk_bf16(r6, r7);
                    *(u32x4*)op = w; }
        }
    }
};
struct EpiRes {
    static constexpr bool PERM = false, AFTER_DRAIN = false;
    const float* base; float* out;
    __device__ __forceinline__ void operator()(const f32x4 (&acc)[2][2][4][2], const Unit& u, int wr, int wc, int fr, int fq) const {
        const int col0 = u.pn * BM + wc * 32 + 4 * fq;
#pragma unroll
        for (int ai = 0; ai < 2; ++ai)
#pragma unroll
            for (int m = 0; m < 4; ++m) { const size_t off = (size_t)(u.pm * BM + ai * HALF + wr * 64 + m * 16 + fr) * 1024 + col0;
#pragma unroll
                for (int bj = 0; bj < 2; ++bj)
#pragma unroll
                    for (int n = 0; n < 2; ++n) { const f32x4 bs = *(const f32x4*)(base + off + bj * HALF + n * 16); *(f32x4*)(out + off + bj * HALF + n * 16) = bs + acc[ai][bj][m][n]; } }
    }
};

struct EpiResNorm {
    static constexpr bool PERM = false, AFTER_DRAIN = true;
    const float* base; float* out; const float* fw; float* xbuf; unsigned* cnt; float eps;
    __device__ __forceinline__ void fused(f32x4 (&acc)[2][2][4][2], const Unit& u, int wr, int wc, int fr, int fq, PG8_LAS unsigned char* lds, int wid, int lane) const {
        PG8_LAS float* Pp = (PG8_LAS float*)lds;
        PG8_LAS float* Sr = (PG8_LAS float*)(lds + 4096);
        const int col0 = u.pn * BM + wc * 32 + 4 * fq;
#pragma unroll
        for (int ai = 0; ai < 2; ++ai)
#pragma unroll
            for (int m = 0; m < 4; ++m) { const int rl = ai * HALF + wr * 64 + m * 16 + fr; const size_t off = (size_t)(u.pm * BM + rl) * 1024 + col0; float s = 0.f;
#pragma unroll
                for (int bj = 0; bj < 2; ++bj)
#pragma unroll
                    for (int n = 0; n < 2; ++n) { const f32x4 xv = *(const f32x4*)(base + off + bj * HALF + n * 16); f32x4 v = acc[ai][bj][m][n] + xv; acc[ai][bj][m][n] = v;
                        s += (v[0] * v[0] + v[1] * v[1]) + (v[2] * v[2] + v[3] * v[3]); }
                s += __shfl_xor(s, 16); s += __shfl_xor(s, 32);
                if (fq == 0) Pp[rl * 4 + wc] = s; }
        asm volatile("s_waitcnt lgkmcnt(0)" ::: "memory"); __builtin_amdgcn_s_barrier(); asm volatile("" ::: "memory");
        const int row = wid * 32 + (lane & 31);
        if (lane < 32) { const float tot = (Pp[row * 4 + 0] + Pp[row * 4 + 1]) + (Pp[row * 4 + 2] + Pp[row * 4 + 3]);
            __hip_atomic_store(xbuf + (size_t)(u.pm * BM + row) * 4 + u.pn, tot, __ATOMIC_RELAXED, __HIP_MEMORY_SCOPE_AGENT); }
        asm volatile("s_waitcnt vmcnt(0)" ::: "memory");
        if (lane == 0) __hip_atomic_fetch_add(cnt + 64 * u.pm, 1u, __ATOMIC_RELAXED, __HIP_MEMORY_SCOPE_AGENT);
        if (wid == 0) {
            unsigned sp = 0;
            for (;;) { if ((unsigned)__builtin_amdgcn_readfirstlane(__hip_atomic_load(cnt + 64 * u.pm, __ATOMIC_RELAXED, __HIP_MEMORY_SCOPE_AGENT)) >= 32u) break;
                if (++sp > (1u << 20)) break; __builtin_amdgcn_s_sleep(2); }
            __builtin_amdgcn_fence(__ATOMIC_ACQUIRE, "agent");
        }
        asm volatile("s_waitcnt vmcnt(0) lgkmcnt(0)" ::: "memory"); __builtin_amdgcn_s_barrier(); asm volatile("" ::: "memory");
        if (lane < 32) { const float* slot = xbuf + (size_t)(u.pm * BM + row) * 4; float tot = 0.f;
#pragma unroll
            for (int t = 0; t < 4; ++t) tot += __hip_atomic_load(slot + t, __ATOMIC_RELAXED, __HIP_MEMORY_SCOPE_AGENT);
            Sr[row] = rsqrtf(tot * (1.0f / 1024.0f) + eps); }
        asm volatile("s_waitcnt lgkmcnt(0)" ::: "memory"); __builtin_amdgcn_s_barrier(); asm volatile("" ::: "memory");
#pragma unroll
        for (int bj = 0; bj < 2; ++bj)
#pragma unroll
            for (int n = 0; n < 2; ++n) { const f32x4 w4 = *(const f32x4*)(fw + col0 + bj * HALF + n * 16);
#pragma unroll
                for (int ai = 0; ai < 2; ++ai)
#pragma unroll
                    for (int m = 0; m < 4; ++m) { const int rl = ai * HALF + wr * 64 + m * 16 + fr; const float rs = Sr[rl];
                        *(f32x4*)(out + (size_t)(u.pm * BM + rl) * 1024 + col0 + bj * HALF + n * 16) = acc[ai][bj][m][n] * rs * w4; } }
    }
};

template <class Epi, class Sched, bool ALIGN_EPI = false, bool SP2 = false>
__device__ __forceinline__ void gemm_phase(PG8_LAS unsigned char* lds, const Gemm g, const Sched& S, const Epi& E) {
    int tid_ = threadIdx.x; asm volatile("" : "+v"(tid_));
    const int tid = tid_, wid = __builtin_amdgcn_readfirstlane(tid >> 6), lane = tid & 63, wr = wid >> 2, wc = wid & 3, fr = lane & 15, fq = lane >> 4;
    const int K = g.K, nt = K / BK;
    unsigned voffA[2], voffB[2];
#pragma unroll
    for (int i = 0; i < 2; ++i) { int R, C; stage_rc(tid * 16 + i * 8192, R, C); const int Rb = Epi::PERM ? ((R & ~31) + perm32(R & 31)) : R;
        voffA[i] = (unsigned)(R * K + C) * 2u; voffB[i] = (unsigned)(Rb * K + C) * 2u; }
    const size_t kstep = (size_t)(BK * 2);
    const size_t hstep = (size_t)HALF * K * 2;
    const size_t tstep = 2 * hstep;
    const unsigned ldsw = (unsigned)wid * 1024u;
    const int aoff = lds_byte(wr * 64 + fr, fq * 8), boff = lds_byte(wc * 32 + fr, fq * 8);
#define PG8_SA(b, h) (((b) * 2 + (h)) * HTB)
#define PG8_SB(b, h) ((4 + (b) * 2 + (h)) * HTB)
#define PG8_STAGE(bufoff, gbase, voff) do { _Pragma("unroll") for (int _i = 0; _i < 2; ++_i) \
        __builtin_amdgcn_global_load_lds((const unsigned*)((const char*)(gbase) + (voff)[_i]), (PG8_LAS unsigned*)(lds + (bufoff) + ldsw + _i * 8192), 16, 0, 0); } while (0)
#define PG8_LDA(dst, b, h) do { _Pragma("unroll") for (int m = 0; m < 4; ++m) _Pragma("unroll") for (int k = 0; k < 2; ++k) dst[m][k] = *(const PG8_LAS bf16x8*)(lds + PG8_SA(b, h) + aoff + m * 2048 + k * 1024); } while (0)
#define PG8_LDB(dst, b, h) do { _Pragma("unroll") for (int n = 0; n < 2; ++n) _Pragma("unroll") for (int k = 0; k < 2; ++k) dst[n][k] = *(const PG8_LAS bf16x8*)(lds + PG8_SB(b, h) + boff + n * 2048 + k * 1024); } while (0)
#define PG8_MMA(ai, bj, At, Bt) do { __builtin_amdgcn_s_setprio(1); _Pragma("unroll") for (int m = 0; m < 4; ++m) _Pragma("unroll") for (int n = 0; n < 2; ++n) _Pragma("unroll") for (int k = 0; k < 2; ++k) \
        acc[ai][bj][m][n] = __builtin_amdgcn_mfma_f32_16x16x32_bf16(Bt[n][k], At[m][k], acc[ai][bj][m][n], 0, 0, 0); __builtin_amdgcn_s_setprio(0); } while (0)
#define PG8_WAIT_V(n) asm volatile("s_waitcnt vmcnt(" #n ")" ::: "memory")
#define PG8_WAIT_L(n) asm volatile("s_waitcnt lgkmcnt(" #n ")" ::: "memory")
#define PG8_BAR __builtin_amdgcn_s_barrier()
#define PG8_SCHED __builtin_amdgcn_sched_barrier(0)
    Unit cur, nxt; int ui = 0;
    if (!S.next(0, cur)) return;
    f32x4 acc[2][2][4][2];
#pragma unroll
    for (int a = 0; a < 2; ++a)
#pragma unroll
        for (int b = 0; b < 2; ++b)
#pragma unroll
            for (int m = 0; m < 4; ++m)
#pragma unroll
                for (int n = 0; n < 2; ++n) acc[a][b][m][n] = (f32x4){0.f, 0.f, 0.f, 0.f};
    bf16x8 At[4][2], B0[2][2], B1[2][2];
    const char* cA = (const char*)g.A + (size_t)cur.pm * tstep; const char* cB = (const char*)g.Bt + (size_t)cur.pn * tstep;
    S.a_ready(cur);
    if constexpr (SP2) {
        PG8_STAGE(PG8_SB(0, 0), cB, voffB); PG8_STAGE(PG8_SB(0, 1), cB + hstep, voffB); PG8_STAGE(PG8_SA(0, 0), cA, voffA); PG8_STAGE(PG8_SA(0, 1), cA + hstep, voffA);
        if (wr == 1) PG8_BAR;
        PG8_WAIT_V(2); PG8_BAR;
        PG8_STAGE(PG8_SB(1, 0), cB + kstep, voffB); PG8_STAGE(PG8_SA(1, 0), cA + kstep, voffA); PG8_STAGE(PG8_SB(1, 1), cB + hstep + kstep, voffB);
        PG8_WAIT_V(6); PG8_BAR;
    } else {
        PG8_STAGE(PG8_SB(0, 0), cB, voffB); PG8_STAGE(PG8_SA(0, 0), cA, voffA); PG8_STAGE(PG8_SB(0, 1), cB + hstep, voffB); PG8_STAGE(PG8_SA(0, 1), cA + hstep, voffA);
        if (wr == 1) PG8_BAR;
        PG8_WAIT_V(4); PG8_BAR;
        PG8_STAGE(PG8_SB(1, 0), cB + kstep, voffB); PG8_STAGE(PG8_SA(1, 0), cA + kstep, voffA); PG8_STAGE(PG8_SB(1, 1), cB + hstep + kstep, voffB);
        PG8_WAIT_V(6); PG8_BAR;
    }
    for (;;) {
        const bool has_next = S.next(ui + 1, nxt);
        const char* nA = has_next ? (const char*)g.A + (size_t)nxt.pm * tstep : cA; const char* nB = has_next ? (const char*)g.Bt + (size_t)nxt.pn * tstep : cB;
        for (int t = 0; t < nt; t += 2) {
            const bool last = (t == nt - 2);
            const char* a1 = cA + (size_t)(t + 1) * kstep;
            const char* a2 = last ? nA : cA + (size_t)(t + 2) * kstep; const char* b2 = last ? nB : cB + (size_t)(t + 2) * kstep;
            const char* a3 = a2 + kstep; const char* b3 = b2 + kstep;
            if (last && has_next) S.a_ready(nxt);
            if constexpr (SP2) {
            PG8_LDB(B0, 0, 0); PG8_LDB(B1, 0, 1); PG8_SCHED; PG8_LDA(At, 0, 0); PG8_STAGE(PG8_SA(1, 1), a1 + hstep, voffA);
            PG8_WAIT_V(8); PG8_WAIT_L(0); PG8_BAR; PG8_MMA(0, 0, At, B0); PG8_MMA(0, 1, At, B1); PG8_BAR; PG8_SCHED;
            PG8_LDA(At, 0, 1); PG8_STAGE(PG8_SB(0, 0), b2, voffB); PG8_STAGE(PG8_SB(0, 1), b2 + hstep, voffB); PG8_STAGE(PG8_SA(0, 0), a2, voffA);
            PG8_WAIT_V(8); PG8_WAIT_L(0); PG8_BAR; PG8_MMA(1, 0, At, B0); PG8_MMA(1, 1, At, B1); PG8_BAR; PG8_SCHED;
            PG8_LDB(B0, 1, 0); PG8_LDB(B1, 1, 1); PG8_SCHED; PG8_LDA(At, 1, 0); PG8_STAGE(PG8_SA(0, 1), a2 + hstep, voffA);
            PG8_WAIT_V(8); PG8_WAIT_L(0); PG8_BAR; PG8_MMA(0, 0, At, B0); PG8_MMA(0, 1, At, B1); PG8_BAR; PG8_SCHED;
            PG8_LDA(At, 1, 1); PG8_STAGE(PG8_SB(1, 0), b3, voffB); PG8_STAGE(PG8_SB(1, 1), b3 + hstep, voffB); PG8_STAGE(PG8_SA(1, 0), a3, voffA);
            PG8_WAIT_V(8); PG8_WAIT_L(0); PG8_BAR; PG8_MMA(1, 0, At, B0); PG8_MMA(1, 1, At, B1); PG8_BAR; PG8_SCHED;
            } else {
            PG8_LDB(B0, 0, 0); PG8_SCHED; PG8_LDA(At, 0, 0); PG8_STAGE(PG8_SA(1, 1), a1 + hstep, voffA);
            PG8_WAIT_L(8); PG8_BAR; PG8_WAIT_L(0); PG8_MMA(0, 0, At, B0); PG8_BAR; PG8_SCHED;
            PG8_LDB(B1, 0, 1); PG8_STAGE(PG8_SB(0, 0), b2, voffB);
            PG8_BAR; PG8_WAIT_L(0); PG8_MMA(0, 1, At, B1); PG8_BAR;
            PG8_LDA(At, 0, 1); PG8_STAGE(PG8_SA(0, 0), a2, voffA);
            PG8_BAR; PG8_WAIT_L(0); PG8_MMA(1, 0, At, B0); PG8_BAR; PG8_SCHED;
            PG8_STAGE(PG8_SB(0, 1), b2 + hstep, voffB);
            PG8_WAIT_V(6); PG8_BAR; PG8_MMA(1, 1, At, B1); PG8_BAR;
            PG8_LDB(B0, 1, 0); PG8_SCHED; PG8_LDA(At, 1, 0); PG8_STAGE(PG8_SA(0, 1), a2 + hstep, voffA);
            PG8_WAIT_L(8); PG8_BAR; PG8_WAIT_L(0); PG8_MMA(0, 0, At, B0); PG8_BAR; PG8_SCHED;
            PG8_LDB(B1, 1, 1); PG8_STAGE(PG8_SB(1, 0), b3, voffB);
            PG8_BAR; PG8_WAIT_L(0); PG8_MMA(0, 1, At, B1); PG8_BAR;
            PG8_LDA(At, 1, 1); PG8_STAGE(PG8_SA(1, 0), a3, voffA);
            PG8_BAR; PG8_WAIT_L(0); PG8_MMA(1, 0, At, B0); PG8_BAR; PG8_SCHED;
            PG8_STAGE(PG8_SB(1, 1), b3 + hstep, voffB);
            PG8_WAIT_V(6); PG8_BAR; PG8_MMA(1, 1, At, B1); PG8_BAR;
            }
        }
        if constexpr (ALIGN_EPI) { if (wr == 0) PG8_BAR; }
        if constexpr (!Epi::AFTER_DRAIN) { E(acc, cur, wr, wc, fr, fq); S.done(cur); }
        if (!has_next) break;
#pragma unroll
        for (int a = 0; a < 2; ++a)
#pragma unroll
            for (int b = 0; b < 2; ++b)
#pragma unroll
                for (int m = 0; m < 4; ++m)
#pragma unroll
                    for (int n = 0; n < 2; ++n) acc[a][b][m][n] = (f32x4){0.f, 0.f, 0.f, 0.f};
        cur = nxt; cA = nA; cB = nB; ++ui;
        if constexpr (ALIGN_EPI) { if (wr == 1) PG8_BAR; }
    }
    PG8_WAIT_V(0);
    if constexpr (!ALIGN_EPI) { if (wr == 0) PG8_BAR; }
    PG8_BAR;
    if constexpr (Epi::AFTER_DRAIN) { E.fused(acc, cur, wr, wc, fr, fq, lds, wid, lane); }
#undef PG8_SA
#undef PG8_SB
#undef PG8_STAGE
#undef PG8_LDA
#undef PG8_LDB
#undef PG8_MMA
#undef PG8_WAIT_V
#undef PG8_WAIT_L
#undef PG8_BAR
#undef PG8_SCHED
}
}

typedef unsigned short bf16_t;
typedef short bf16x8 __attribute__((ext_vector_type(8)));
typedef float f32x4 __attribute__((ext_vector_type(4)));
typedef float f32x16 __attribute__((ext_vector_type(16)));
typedef unsigned u32x4 __attribute__((ext_vector_type(4)));
typedef unsigned u32x2 __attribute__((ext_vector_type(2)));
#define LAS __attribute__((address_space(3)))

constexpr int SEQ = 16384, DM = 1024, DIN = 6168, NMAIN = 6144;
constexpr float EPS = 1e-6f;
constexpr size_t MiB = 1u << 20;
constexpr size_t WS_CT = 0;
constexpr size_t WS_GL = 64 * 1024;
constexpr size_t WS_BAR = 128 * 1024;
constexpr size_t WS_PCNT = 144 * 1024;
constexpr size_t WS_XB = 256 * 1024;
constexpr size_t WS_SMALL = 1 * MiB;
constexpr size_t WS_CL = 3 * MiB;
constexpr size_t WS_WSM = 4 * MiB;
constexpr size_t WS_WUPA = 5 * MiB, WS_WUPB = 6 * MiB, WS_WOUT = 7 * MiB, WS_WIN = 9 * MiB;
constexpr size_t WS_H = 21 * MiB;
constexpr size_t WS_WB = WS_H, WS_VT = WS_H + 16 * MiB;
constexpr size_t WS_PROJ = 53 * MiB;
constexpr size_t BUF_ELEMS = (size_t)SEQ * 512;
constexpr size_t WS_PG = 246 * MiB;
constexpr size_t WS_QG = 248 * MiB;
constexpr size_t WS_END = 252 * MiB;
constexpr int LDS_BYTES = 151552;

struct Params { const float* in[16]; float* out; unsigned char* ws; };

DI float bflo(unsigned u) { return __uint_as_float(u << 16); }
DI float bfhi(unsigned u) { return __uint_as_float(u & 0xffff0000u); }
DI float bf2f(bf16_t v) { return __uint_as_float(((unsigned)v) << 16); }
typedef float f32x2_t __attribute__((ext_vector_type(2))); typedef __bf16 bf16x2_t __attribute__((ext_vector_type(2)));
DI unsigned pk2(float lo, float hi) { f32x2_t v = {lo, hi}; bf16x2_t b = __builtin_convertvector(v, bf16x2_t); return __builtin_bit_cast(unsigned, b); }
DI float wave_sum(float v) {
#pragma unroll
    for (int o = 1; o < 64; o <<= 1) v += __shfl_xor(v, o);
    return v;
}
DI float wave_max(float v) {
#pragma unroll
    for (int o = 1; o < 64; o <<= 1) v = fmaxf(v, __shfl_xor(v, o));
    return v;
}
DI float dpp_xor1(float v) { return __int_as_float(__builtin_amdgcn_update_dpp(0, __float_as_int(v), 0xB1, 0xf, 0xf, false)); }
DI float dpp_xor2(float v) { return __int_as_float(__builtin_amdgcn_update_dpp(0, __float_as_int(v), 0x4E, 0xf, 0xf, false)); }
DI float dpp_half_mirror(float v) { return __int_as_float(__builtin_amdgcn_update_dpp(0, __float_as_int(v), 0x141, 0xf, 0xf, false)); }
DI float wave_incl_scan(float v) {
#define SCAN_DPP(ctrl, rmask) v += __int_as_float(__builtin_amdgcn_update_dpp(0, __float_as_int(v), ctrl, rmask, 0xf, false))
    SCAN_DPP(0x111, 0xf); SCAN_DPP(0x112, 0xf); SCAN_DPP(0x114, 0xf); SCAN_DPP(0x118, 0xf); SCAN_DPP(0x142, 0xa); SCAN_DPP(0x143, 0xc);
#undef SCAN_DPP
    return v;
}
DI float sigmf(float v) { return __builtin_amdgcn_rcpf(1.0f + __expf(-v)); }
DI float softplusf(float v) { return v > 20.f ? v : __logf(1.0f + __expf(v)); }
#define MFMA16(a, b, c) __builtin_amdgcn_mfma_f32_16x16x32_bf16((a), (b), (c), 0, 0, 0)
#define MFMA32(a, b, c) __builtin_amdgcn_mfma_f32_32x32x16_bf16((a), (b), (c), 0, 0, 0)
#define LDSFENCE() asm volatile("s_waitcnt lgkmcnt(0)" ::: "memory")

DI void p0_transpose_item(const float* W, int ldN, int srccol, bf16_t* WT, int K, int destrow, int k0, float* scr, int lane) {
    float tv[32];
#pragma unroll
    for (int i = 0; i < 32; ++i) { const int kk = 2 * i + (lane >> 5); tv[i] = W[(size_t)(k0 + kk) * ldN + srccol + (lane & 31)]; }
#pragma unroll
    for (int i = 0; i < 32; ++i) { const int kk = 2 * i + (lane >> 5); scr[kk * 33 + (lane & 31)] = tv[i]; }
    LDSFENCE();
    const int c = lane & 7;
#pragma unroll
    for (int j = 0; j < 4; ++j) { const int n = (lane >> 3) + 8 * j; const float* s = scr + (8 * c) * 33 + n;
        u32x4 o; o.x = pk2(s[0 * 33], s[1 * 33]); o.y = pk2(s[2 * 33], s[3 * 33]); o.z = pk2(s[4 * 33], s[5 * 33]); o.w = pk2(s[6 * 33], s[7 * 33]);
        *(u32x4*)(WT + (size_t)(destrow + n) * K + k0 + 8 * c) = o; }
    LDSFENCE();
}

DI void phase0(const Params& P, unsigned char* lds, int tid, int G) {
    const int lane = tid & 63, wave = tid >> 6;
    unsigned char* ws = P.ws;
    float* scr = (float*)(lds + wave * 16384);
    const int gw = blockIdx.x * 8 + wave, NGW = G * 8;
    const float* Win = P.in[2];
    constexpr int I_IN = 16 * 192, I_UP = 8 * 32, I_OUT = 16 * 32;
    for (int it = gw; it < I_IN + 2 * I_UP + I_OUT; it += NGW) {
        int r = it;
        if (r < I_IN) { const int kb = r / 192, nb = r % 192, n0 = 32 * nb; const int src = n0 < 2048 ? n0 : (n0 < 4096 ? n0 + 16 : n0 + 24);
            p0_transpose_item(Win, DIN, src, (bf16_t*)(ws + WS_WIN), 1024, n0, 64 * kb, scr, lane); continue; }
        r -= I_IN;
        if (r < I_UP) { p0_transpose_item(P.in[12], 1024, 32 * (r % 32), (bf16_t*)(ws + WS_WUPA), 512, 32 * (r % 32), 64 * (r / 32), scr, lane); continue; }
        r -= I_UP;
        if (r < I_UP) { p0_transpose_item(P.in[13], 1024, 32 * (r % 32), (bf16_t*)(ws + WS_WUPB), 512, 32 * (r % 32), 64 * (r / 32), scr, lane); continue; }
        r -= I_UP;
        p0_transpose_item(P.in[14], 1024, 32 * (r % 32), (bf16_t*)(ws + WS_WOUT), 1024, 32 * (r % 32), 64 * (r / 32), scr, lane);
    }
    { bf16_t* wsm = (bf16_t*)(ws + WS_WSM);
      for (int idx = blockIdx.x * 512 + tid; idx < 32 * 1024; idx += G * 512) { const int n = idx >> 10, k = idx & 1023;
          float v = 0.f; if (n < 16) v = Win[(size_t)k * DIN + 2048 + n]; else if (n < 24) v = Win[(size_t)k * DIN + 4112 + (n - 16)];
          wsm[idx] = (bf16_t)(pk2(v, 0.f) & 0xffffu); } }
    { const float* x = P.in[0]; const float* nw = P.in[1]; bf16_t* H = (bf16_t*)(ws + WS_H);
      f32x4 wv[4];
#pragma unroll
      for (int j = 0; j < 4; ++j) wv[j] = *(const f32x4*)(nw + 4 * lane + 256 * j);
      for (int m0 = gw; m0 < SEQ; m0 += 4 * NGW) {
          f32x4 v[4][4];
#pragma unroll
          for (int q = 0; q < 4; ++q) { const int m = m0 + q * NGW < SEQ ? m0 + q * NGW : m0; const f32x4* xr = (const f32x4*)(x + (size_t)m * DM) + lane;
#pragma unroll
              for (int j = 0; j < 4; ++j) v[q][j] = xr[64 * j]; }
#pragma unroll
          for (int q = 0; q < 4; ++q) { const int m = m0 + q * NGW; if (m < SEQ) { float s = 0.f;
#pragma unroll
              for (int j = 0; j < 4; ++j) s += (v[q][j].x * v[q][j].x + v[q][j].y * v[q][j].y) + (v[q][j].z * v[q][j].z + v[q][j].w * v[q][j].w);
              const float rstd = rsqrtf(wave_sum(s) * (1.f / DM) + EPS);
              u32x2* o8 = (u32x2*)(H + (size_t)m * DM) + lane;
#pragma unroll
              for (int j = 0; j < 4; ++j) { u32x2 o; o.x = pk2(v[q][j].x * rstd * wv[j].x, v[q][j].y * rstd * wv[j].y); o.y = pk2(v[q][j].z * rstd * wv[j].z, v[q][j].w * rstd * wv[j].w); o8[64 * j] = o; } } }
      } }
}

DI void small_proj(const Params& P, unsigned char* lds, int tid, int G) {
    const int lane = tid & 63, wave = tid >> 6;
    const bf16_t* H = (const bf16_t*)(P.ws + WS_H); const bf16_t* W = (const bf16_t*)(P.ws + WS_WSM); float* SM = (float*)(P.ws + WS_SMALL);
    const int r32 = lane & 31, hi = lane >> 5, ru = wave >> 2, kq = wave & 3;
    float* part = (float*)lds;
    for (int u2 = blockIdx.x; u2 < SEQ / 64; u2 += G) {
        const int u = 2 * u2 + ru;
        f32x16 acc; for (int i = 0; i < 16; ++i) acc[i] = 0.f;
        const bf16_t* ap = H + (size_t)(u * 32 + r32) * DM + 256 * kq + 8 * hi; const bf16_t* bp = W + (size_t)r32 * DM + 256 * kq + 8 * hi;
        bf16x8 a[16], b[16];
#pragma unroll
        for (int ks = 0; ks < 16; ++ks) { a[ks] = *(const bf16x8*)(ap + 16 * ks); b[ks] = *(const bf16x8*)(bp + 16 * ks); }
#pragma unroll
        for (int ks = 0; ks < 16; ++ks) acc = MFMA32(a[ks], b[ks], acc);
#pragma unroll
        for (int r = 0; r < 16; ++r) part[(wave * 16 + r) * 64 + lane] = acc[r];
        __syncthreads();
#pragma unroll
        for (int k = 0; k < 4; ++k) { const int o = tid + 512 * k, uu = o >> 10, r = (o >> 6) & 15, l = o & 63;
            const float v = part[((uu * 4 + 0) * 16 + r) * 64 + l] + part[((uu * 4 + 1) * 16 + r) * 64 + l] + part[((uu * 4 + 2) * 16 + r) * 64 + l] + part[((uu * 4 + 3) * 16 + r) * 64 + l];
            const int row = (r & 3) + 8 * (r >> 2) + 4 * (l >> 5);
            SM[(size_t)((2 * u2 + uu) * 32 + row) * 32 + (l & 31)] = v; }
        __syncthreads();
    }
}

DI int permpos(int a) { return 32 * (a >> 5) + 8 * ((a >> 2) & 3) + 4 * ((a >> 4) & 1) + (a & 3); }
#define PREP_BAR() do { asm volatile("s_waitcnt lgkmcnt(0)\n\ts_barrier" ::: "memory"); } while (0)
DI void gdn_load(const Params& P, int u, int tid, u32x4 (&raw)[12], float& sb, float& sa) {
    const int h = u & 7, n = u >> 3, t = tid >> 3, c8 = tid & 7, tok = n * 64 + t;
    const bf16_t* PROJ = (const bf16_t*)(P.ws + WS_PROJ); const float* SM = (const float*)(P.ws + WS_SMALL);
#pragma unroll
    for (int xx = 0; xx < 3; ++xx)
#pragma unroll
        for (int j = 0; j < 4; ++j) { const int tk = tok - 3 + j; u32x4 v = {0u, 0u, 0u, 0u};
            if (tk >= 0) v = *(const u32x4*)(PROJ + (size_t)xx * BUF_ELEMS + h * 64 + 8 * c8 + (size_t)tk * 512);
            raw[xx * 4 + j] = v; }
    sb = SM[(size_t)tok * 32 + h]; sa = SM[(size_t)tok * 32 + 8 + h];
}
DI void gdn_prep_unit(const Params& P, int h, int n, unsigned char* lds, int tid, u32x4 (&raw)[12], float& sbv, float& sav, int unext, bool cw_lds = false) {
    unsigned char* ws = P.ws;
    bf16_t* Kimg = (bf16_t*)(lds); bf16_t* Qimg = (bf16_t*)(lds + 9216);
    float* Ml = (float*)(lds + 18432); float* X = (float*)(lds + 35840);
    float* graw = (float*)(lds + 69632); float* gcs = graw + 64; float* bet = graw + 128;
    bf16_t* Aimg = (bf16_t*)(lds + 76800);
    const bf16_t* PROJ = (const bf16_t*)(ws + WS_PROJ); const float* SM = (const float*)(ws + WS_SMALL);
    const float* convw = P.in[4];
    const int unit = h * 256 + n;
    bf16_t* IMG = (bf16_t*)P.out + (size_t)unit * 16384;
    const int lane = tid & 63, wave = __builtin_amdgcn_readfirstlane(tid >> 6);
    const int t = tid >> 3, c8 = tid & 7, tok = n * 64 + t;
    float y[3][8];
#pragma unroll
    for (int xx = 0; xx < 3; ++xx) {
        float acc[8];
#pragma unroll
        for (int e = 0; e < 8; ++e) acc[e] = 0.f;
#pragma unroll
        for (int j = 0; j < 4; ++j) { const u32x4 rw = raw[xx * 4 + j];
            const float* wp = cw_lds ? (const float*)(lds + 86016) + (j * 3 + xx) * 64 + 8 * c8 : convw + j * 1536 + xx * 512 + h * 64 + 8 * c8;
            const f32x4 w0 = *(const f32x4*)wp, w1 = *(const f32x4*)(wp + 4);
            acc[0] += w0.x * bflo(rw.x); acc[1] += w0.y * bfhi(rw.x); acc[2] += w0.z * bflo(rw.y); acc[3] += w0.w * bfhi(rw.y);
            acc[4] += w1.x * bflo(rw.z); acc[5] += w1.y * bfhi(rw.z); acc[6] += w1.z * bflo(rw.w); acc[7] += w1.w * bfhi(rw.w); }
#pragma unroll
        for (int e = 0; e < 8; ++e) y[xx][e] = acc[e] * sigmf(acc[e]);
    }
    const float sb_c = sbv, sa_c = sav;
    float ssq = 0.f, ssk = 0.f;
#pragma unroll
    for (int e = 0; e < 8; ++e) { ssq += y[0][e] * y[0][e]; ssk += y[1][e] * y[1][e]; }
    ssq += dpp_xor1(ssq); ssq += dpp_xor2(ssq); ssq += dpp_half_mirror(ssq);
    ssk += dpp_xor1(ssk); ssk += dpp_xor2(ssk); ssk += dpp_half_mirror(ssk);
    const float rq = rsqrtf(ssq + EPS) * 0.125f, rk = rsqrtf(ssk + EPS);
    const float beta = sigmf(sb_c);
    const float gt = -__expf(P.in[5][h]) * softplusf(sa_c + P.in[6][h]);
    graw[t] = gt; bet[t] = beta;
    PREP_BAR();
    if (wave == 0) gcs[lane] = wave_incl_scan(graw[lane]);
    PREP_BAR();
    const float gc = gcs[t];
    const float eg = __expf(gc);
    { u32x4 kk, qq; float q[8], k[8];
#pragma unroll
      for (int e = 0; e < 8; ++e) { q[e] = y[0][e] * rq; k[e] = y[1][e] * rk; }
      kk.x = pk2(k[0], k[1]); kk.y = pk2(k[2], k[3]); kk.z = pk2(k[4], k[5]); kk.w = pk2(k[6], k[7]);
      qq.x = pk2(q[0], q[1]); qq.y = pk2(q[2], q[3]); qq.z = pk2(q[4], q[5]); qq.w = pk2(q[6], q[7]);
      *(u32x4*)(Kimg + t * 72 + 8 * c8) = kk; *(u32x4*)(Qimg + t * 72 + 8 * c8) = qq;
#pragma unroll
      for (int e = 0; e < 8; e += 4) { const float kb = beta * eg;
          *(f32x4*)(X + t * 132 + 8 * c8 + e) = (f32x4){y[2][e] * beta, y[2][e + 1] * beta, y[2][e + 2] * beta, y[2][e + 3] * beta};
          *(f32x4*)(X + t * 132 + 64 + 8 * c8 + e) = (f32x4){k[e] * kb, k[e + 1] * kb, k[e + 2] * kb, k[e + 3] * kb}; }
      const int p0 = 32 * (c8 >> 2) + 16 * (c8 & 1) + 4 * ((c8 >> 1) & 1);
      u32x2 a, b; a.x = pk2(q[0] * eg, q[1] * eg); a.y = pk2(q[2] * eg, q[3] * eg); b.x = pk2(q[4] * eg, q[5] * eg); b.y = pk2(q[6] * eg, q[7] * eg);
      const int swt = (t >> 1) & 7, ch0 = p0 >> 3, wi = p0 & 7;
      *(u32x2*)(IMG + 4096 + t * 64 + ((ch0 ^ swt) << 3) + wi) = a; *(u32x2*)(IMG + 4096 + t * 64 + (((ch0 + 1) ^ swt) << 3) + wi) = b; }
    PREP_BAR();
    { const int l15 = lane & 15, g = lane >> 4;
#pragma unroll
      for (int bb = 0; bb < 2; ++bb) { const int blk = 2 * wave + bb, bi = blk >> 2, bj = blk & 3;
          f32x4 aq = {0.f, 0.f, 0.f, 0.f}, ak = {0.f, 0.f, 0.f, 0.f};
#pragma unroll
          for (int s = 0; s < 2; ++s) {
              const bf16x8 bk = *(const bf16x8*)(Kimg + (16 * bj + l15) * 72 + 32 * s + 8 * g);
              const bf16x8 aqf = *(const bf16x8*)(Qimg + (16 * bi + l15) * 72 + 32 * s + 8 * g);
              aq = MFMA16(aqf, bk, aq);
              if (bj <= bi) { const bf16x8 akf = *(const bf16x8*)(Kimg + (16 * bi + l15) * 72 + 32 * s + 8 * g); ak = MFMA16(akf, bk, ak); }
          }
          const int j = 16 * bj + l15; const float gj = gcs[j]; const int pj = permpos(j);
          const f32x4 gi4 = *(const f32x4*)(gcs + 16 * bi + 4 * g), be4 = *(const f32x4*)(bet + 16 * bi + 4 * g);
#pragma unroll
          for (int r = 0; r < 4; ++r) { const int i = 16 * bi + 4 * g + r; const float de_ = __expf(fminf(gi4[r] - gj, 0.f)); const float dec = (j <= i) ? de_ : 0.f;
              Aimg[i * 64 + ((((pj >> 3) ^ (i >> 1)) & 7) << 3) + (pj & 7)] = (bf16_t)(pk2(aq[r] * dec, 0.f) & 0xffffu);
              if (bj <= bi) Ml[i * 68 + j] = (j < i) ? be4[r] * ak[r] * dec : 0.f; }
      } }
    PREP_BAR();
    if (unext >= 0) gdn_load(P, unext, tid, raw, sbv, sav);
    float* Tl = (float*)(lds + 70400);
    if (wave < 4) { const int b = wave, col = lane >> 2, q4 = lane & 3;
      float xr[4] = {0.f, 0.f, 0.f, 0.f};
#pragma unroll
      for (int p = 0; p < 8; ++p) { const int i0 = 2 * p, i1 = 2 * p + 1;
          const float* d0 = Ml + (16 * b + i0) * 68 + 16 * b; const float* d1 = Ml + (16 * b + i1) * 68 + 16 * b;
          float p0 = 0.f, p1 = 0.f;
#pragma unroll
          for (int m = 0; m < (i1 + 3) / 4; ++m) { p0 += d0[4 * m + q4] * xr[m]; p1 += d1[4 * m + q4] * xr[m]; }
          p0 += dpp_xor1(p0); p1 += dpp_xor1(p1); p0 += dpp_xor2(p0); p1 += dpp_xor2(p1);
          const float x0 = (i0 == col ? 1.f : 0.f) - p0;
          const float x1 = (i1 == col ? 1.f : 0.f) - p1 - d1[i0] * x0;
          if (q4 == (i0 & 3)) xr[i0 >> 2] = x0;
          if (q4 == (i1 & 3)) xr[i1 >> 2] = x1;
          Tl[(16 * b + i0) * 20 + col] = x0; Tl[(16 * b + i1) * 20 + col] = x1;
      } }
    else {
      const float glast = gcs[63];
#pragma unroll
      for (int k2 = 0; k2 < 2; ++k2) { const int it_ = (tid - 256) + 256 * k2, c = it_ >> 3, pg = it_ & 7, s = pg >> 2, g = pg & 3;
          float w[8];
#pragma unroll
          for (int j = 0; j < 8; ++j) { const int d = 32 * s + 16 * (j >> 2) + 4 * g + (j & 3); w[j] = bf2f(Kimg[d * 72 + c]) * __expf(glast - gcs[d]); }
          u32x4 o2; o2.x = pk2(w[0], w[1]); o2.y = pk2(w[2], w[3]); o2.z = pk2(w[4], w[5]); o2.w = pk2(w[6], w[7]);
          *(u32x4*)(IMG + 12288 + c * 64 + 8 * ((pg ^ (c >> 1)) & 7)) = o2;
          *(u32x4*)(IMG + 8192 + it_ * 8) = *(const u32x4*)(Aimg + it_ * 8); }
      if (tid == 256) ((float*)(ws + WS_GL))[unit] = __expf(glast); }
    PREP_BAR();
    { const int l15 = lane & 15, g = lane >> 4;
      u32x2 xh[4];
#pragma unroll
      for (int b = 0; b < 4; ++b) {
          float* xp = X + (16 * b + 4 * g) * 132 + 16 * wave + l15;
          f32x4 acc = {xp[0], xp[132], xp[264], xp[396]};
#pragma unroll
          for (int bp = 0; bp < b; bp += 2) {
              const f32x4 a0 = *(const f32x4*)(Ml + (16 * b + l15) * 68 + 16 * bp + 4 * g);
              f32x4 a1 = {0.f, 0.f, 0.f, 0.f}; u32x2 x1 = {0u, 0u};
              if (bp + 1 < b) { a1 = *(const f32x4*)(Ml + (16 * b + l15) * 68 + 16 * (bp + 1) + 4 * g); x1 = xh[bp + 1]; }
              u32x4 ap; ap.x = pk2(-a0[0], -a0[1]); ap.y = pk2(-a0[2], -a0[3]); ap.z = pk2(-a1[0], -a1[1]); ap.w = pk2(-a1[2], -a1[3]);
              u32x4 bpk; bpk.x = xh[bp].x; bpk.y = xh[bp].y; bpk.z = x1.x; bpk.w = x1.y;
              acc = MFMA16(__builtin_bit_cast(bf16x8, ap), __builtin_bit_cast(bf16x8, bpk), acc); }
          const f32x4 tt = *(const f32x4*)(Tl + (16 * b + l15) * 20 + 4 * g);
          f32x4 xb = {0.f, 0.f, 0.f, 0.f};
          { u32x4 tp; tp.x = pk2(tt[0], tt[1]); tp.y = pk2(tt[2], tt[3]); tp.z = 0u; tp.w = 0u;
            u32x4 rp; rp.x = pk2(acc[0], acc[1]); rp.y = pk2(acc[2], acc[3]); rp.z = 0u; rp.w = 0u;
            xb = MFMA16(__builtin_bit_cast(bf16x8, tp), __builtin_bit_cast(bf16x8, rp), xb); }
          xh[b].x = pk2(xb[0], xb[1]); xh[b].y = pk2(xb[2], xb[3]);
          xp[0] = xb[0]; xp[132] = xb[1]; xp[264] = xb[2]; xp[396] = xb[3];
      } }
    PREP_BAR();
    { bf16_t* WB = (bf16_t*)(ws + WS_WB) + (size_t)unit * 4096;
#pragma unroll
      for (int k = 0; k < 2; ++k) { const int gidx = tid + 512 * k, cgi = gidx >> 8, mb = (gidx >> 6) & 3, l = gidx & 63;
          const float* xp = X + (16 * mb + 4 * (l >> 4)) * 132 + 16 * cgi + (l & 15);
          u32x2 o; o.x = pk2(xp[0], xp[132]); o.y = pk2(xp[264], xp[396]); *(u32x2*)(WB + gidx * 4) = o; }
      const int c = tid >> 3, pg = tid & 7, s = pg >> 2, g = pg & 3;
      float v[8];
#pragma unroll
      for (int j = 0; j < 8; ++j) { const int d = 32 * s + 16 * (j >> 2) + 4 * g + (j & 3); v[j] = -X[c * 132 + 64 + d]; }
      u32x4 o1; o1.x = pk2(v[0], v[1]); o1.y = pk2(v[2], v[3]); o1.z = pk2(v[4], v[5]); o1.w = pk2(v[6], v[7]);
      *(u32x4*)(IMG + c * 64 + 8 * ((pg ^ (c >> 1)) & 7)) = o1; }
}

DI void fox_prep_unit(const Params& P, int n, unsigned char* lds, int tid) {
    unsigned char* ws = P.ws;
    const int h = tid >> 6, t = tid & 63, tok = n * 64 + t;
    bf16_t* FQ = (bf16_t*)(ws + WS_PROJ) + 4 * BUF_ELEMS + (size_t)tok * 512 + h * 64;
    bf16_t* FK = (bf16_t*)(ws + WS_PROJ) + 5 * BUF_ELEMS + (size_t)tok * 512 + h * 64;
    const bf16_t* FV = (const bf16_t*)(ws + WS_PROJ) + 6 * BUF_ELEMS + (size_t)tok * 512 + h * 64;
#pragma unroll
    for (int which = 0; which < 2; ++which) {
        bf16_t* ptr = which ? FK : FQ; const float* nw = which ? P.in[10] : P.in[9]; const float sc = which ? 1.0f : 0.125f * 1.4426950408889634f;
        u32x4 raw[8]; float ss = 0.f;
#pragma unroll
        for (int i = 0; i < 8; ++i) { raw[i] = *(const u32x4*)(ptr + 8 * i);
            const float a0 = bflo(raw[i].x), a1 = bfhi(raw[i].x), a2 = bflo(raw[i].y), a3 = bfhi(raw[i].y), a4 = bflo(raw[i].z), a5 = bfhi(raw[i].z), a6 = bflo(raw[i].w), a7 = bfhi(raw[i].w);
            ss += (a0 * a0 + a1 * a1) + (a2 * a2 + a3 * a3) + (a4 * a4 + a5 * a5) + (a6 * a6 + a7 * a7); }
        const float rstd = rsqrtf(ss * (1.f / 64.f) + EPS) * sc;
#pragma unroll
        for (int i = 0; i < 8; ++i) { const f32x4 w0 = *(const f32x4*)(nw + 8 * i), w1 = *(const f32x4*)(nw + 8 * i + 4); u32x4 o;
            o.x = pk2(bflo(raw[i].x) * rstd * w0.x, bfhi(raw[i].x) * rstd * w0.y); o.y = pk2(bflo(raw[i].y) * rstd * w0.z, bfhi(raw[i].y) * rstd * w0.w);
            o.z = pk2(bflo(raw[i].z) * rstd * w1.x, bfhi(raw[i].z) * rstd * w1.y); o.w = pk2(bflo(raw[i].w) * rstd * w1.z, bfhi(raw[i].w) * rstd * w1.w);
            *(u32x4*)(ptr + 8 * i) = o; }
    }
    { bf16_t* tile = (bf16_t*)(lds + h * 9216);
#pragma unroll
      for (int i = 0; i < 8; ++i) { const u32x4 r = *(const u32x4*)(FV + 8 * i);
          tile[(8 * i + 0) * 72 + t] = (bf16_t)(r.x & 0xffffu); tile[(8 * i + 1) * 72 + t] = (bf16_t)(r.x >> 16);
          tile[(8 * i + 2) * 72 + t] = (bf16_t)(r.y & 0xffffu); tile[(8 * i + 3) * 72 + t] = (bf16_t)(r.y >> 16);
          tile[(8 * i + 4) * 72 + t] = (bf16_t)(r.z & 0xffffu); tile[(8 * i + 5) * 72 + t] = (bf16_t)(r.z >> 16);
          tile[(8 * i + 6) * 72 + t] = (bf16_t)(r.w & 0xffffu); tile[(8 * i + 7) * 72 + t] = (bf16_t)(r.w >> 16); }
      LDSFENCE();
      bf16_t* VT = (bf16_t*)(ws + WS_VT) + (size_t)(h * 64) * SEQ + (size_t)n * 64;
#pragma unroll
      for (int k = 0; k < 8; ++k) { const int idx = t + 64 * k, d = idx >> 3, c = idx & 7;
          *(u32x4*)(VT + (size_t)d * SEQ + 8 * c) = *(const u32x4*)(tile + d * 72 + 8 * c); }
      LDSFENCE(); }
    { const float f = ((const float*)(ws + WS_SMALL))[(size_t)tok * 32 + 16 + h] + P.in[8][h];
      float v = -softplusf(-f) * 1.4426950408889634f;
      v = wave_incl_scan(v);
      ((float*)(ws + WS_CL))[(size_t)h * SEQ + tok] = v;
      if (t == 63) ((float*)(ws + WS_CT))[h * 256 + n] = v; }
}

constexpr int SCAN_L = 8, SCAN_G = 256 / SCAN_L;
#define SCAN_BAR() do { __builtin_amdgcn_sched_barrier(0); asm volatile("s_waitcnt lgkmcnt(0)\n\ts_barrier" ::: "memory"); __builtin_amdgcn_sched_barrier(0); } while (0)
#define ORDER_FENCE() do { asm volatile("" ::: "memory"); __builtin_amdgcn_sched_barrier(0); } while (0)
DI bf16x8 pack8(const f32x4& a, const f32x4& b) { u32x4 p; p.x = pk2(a[0], a[1]); p.y = pk2(a[2], a[3]); p.z = pk2(b[0], b[1]); p.w = pk2(b[2], b[3]); return __builtin_bit_cast(bf16x8, p); }
template <bool PASS1>
DI void gdn_scan(const Params& P, int h, int g, unsigned char* lds, LAS unsigned char* ldsl, int tid) {
    unsigned char* ws = P.ws;
    const int lane = tid & 63, wave = __builtin_amdgcn_readfirstlane(tid >> 6);
    const int c0 = g * SCAN_L;
    bf16_t* obuf = (bf16_t*)(lds + 131072);
    float* gll = (float*)(lds + 149504);
    const bf16_t* IMGH = (const bf16_t*)P.out + (size_t)(h * 256 + c0) * 16384;
    const float* GLp = (const float*)(ws + WS_GL) + h * 256 + c0;
    bf16_t* PIMG = (bf16_t*)(ws + WS_PG);
    float* QACC = (float*)(ws + WS_QG);
    if (wave >= 6) {
        if constexpr (PASS1) {
            for (int n = 0; n <= SCAN_L; ++n) SCAN_BAR();
        } else {
        const int ftid = tid - 384, tl = ftid >> 1, e0 = 32 * (ftid & 1);
        float gw[32];
#pragma unroll
        for (int e = 0; e < 32; ++e) gw[e] = P.in[7][e0 + e];
        const bf16_t* GZ = (const bf16_t*)(ws + WS_PROJ) + 3 * BUF_ELEMS + h * 64 + e0 + (size_t)(c0 * 64 + tl) * 512;
        bf16_t* YA = (bf16_t*)(ws + WS_PROJ) + 0 * BUF_ELEMS + h * 64 + e0 + (size_t)(c0 * 64 + tl) * 512;
        u32x4 Z0[4], Z1[4], Z2[4], Z3[4];
#define LDZ(Z, u_) do { const int uu_ = (u_) < SCAN_L ? (u_) : SCAN_L - 1; _Pragma("unroll") for (int i = 0; i < 4; ++i) Z[i] = *(const u32x4*)(GZ + (size_t)uu_ * 32768 + 8 * i); } while (0)
#define FSIG(z) __builtin_amdgcn_rcpf(1.0f + __expf(-(z)))
#define FIN_STEP(Z, nn_) do { const int nn = (nn_); \
            const bf16_t* ob = obuf + (nn & 1) * 4608 + tl * 72 + e0; \
            float of[32]; float ss = 0.f; \
            _Pragma("unroll") for (int i = 0; i < 4; ++i) { const u32x4 ov = *(const u32x4*)(ob + 8 * i); \
                of[8 * i] = bflo(ov.x); of[8 * i + 1] = bfhi(ov.x); of[8 * i + 2] = bflo(ov.y); of[8 * i + 3] = bfhi(ov.y); \
                of[8 * i + 4] = bflo(ov.z); of[8 * i + 5] = bfhi(ov.z); of[8 * i + 6] = bflo(ov.w); of[8 * i + 7] = bfhi(ov.w); } \
            _Pragma("unroll") for (int e = 0; e < 32; ++e) ss += of[e] * of[e]; \
            ss += dpp_xor1(ss); \
            const float rstd = rsqrtf(ss * (1.f / 64.f) + EPS); \
            _Pragma("unroll") for (int i = 0; i < 4; ++i) { \
                const float z0 = bflo(Z[i].x), z1 = bfhi(Z[i].x), z2 = bflo(Z[i].y), z3 = bfhi(Z[i].y), z4 = bflo(Z[i].z), z5 = bfhi(Z[i].z), z6 = bflo(Z[i].w), z7 = bfhi(Z[i].w); \
                u32x4 w; \
                w.x = pk2(of[8 * i] * rstd * gw[8 * i] * z0 * FSIG(z0), of[8 * i + 1] * rstd * gw[8 * i + 1] * z1 * FSIG(z1)); \
                w.y = pk2(of[8 * i + 2] * rstd * gw[8 * i + 2] * z2 * FSIG(z2), of[8 * i + 3] * rstd * gw[8 * i + 3] * z3 * FSIG(z3)); \
                w.z = pk2(of[8 * i + 4] * rstd * gw[8 * i + 4] * z4 * FSIG(z4), of[8 * i + 5] * rstd * gw[8 * i + 5] * z5 * FSIG(z5)); \
                w.w = pk2(of[8 * i + 6] * rstd * gw[8 * i + 6] * z6 * FSIG(z6), of[8 * i + 7] * rstd * gw[8 * i + 7] * z7 * FSIG(z7)); \
                *(u32x4*)(YA + (size_t)nn * 32768 + 8 * i) = w; } \
            LDZ(Z, nn + 4); } while (0)
        LDZ(Z0, 0); ORDER_FENCE(); LDZ(Z1, 1); ORDER_FENCE(); LDZ(Z2, 2); ORDER_FENCE(); LDZ(Z3, 3); ORDER_FENCE();
        if (g > 0) for (int i = 0; i <= g; ++i) SCAN_BAR();
        SCAN_BAR();
        SCAN_BAR();
        for (int nb = 0; nb < SCAN_L; nb += 4) {
            FIN_STEP(Z0, nb); SCAN_BAR(); FIN_STEP(Z1, nb + 1); SCAN_BAR(); FIN_STEP(Z2, nb + 2); SCAN_BAR(); FIN_STEP(Z3, nb + 3); if (nb + 3 < SCAN_L - 1) SCAN_BAR();
        }
#undef FIN_STEP
#undef FSIG
#undef LDZ
        }
    } else if (wave >= 4) {
        const int dw = wave - 4;
        constexpr int NP = PASS1 ? 8 : 16;
        const int piece0 = PASS1 ? 24 * dw : 16 * dw;
#define DMA_UNIT(u, slot) do { const char* src_ = (const char*)(IMGH + (size_t)(u) * 16384) + piece0 * 1024 + lane * 16; \
        _Pragma("unroll") for (int k_ = 0; k_ < NP; ++k_) __builtin_amdgcn_global_load_lds((const unsigned*)(src_ + k_ * 1024), (LAS unsigned*)(ldsl + (slot) * 32768 + (piece0 + k_) * 1024), 16, 0, 0); } while (0)
        if constexpr (!PASS1) { if (g > 0) {
            const char* pq_p = (const char*)(PIMG + (size_t)(h * SCAN_G) * 4096) + dw * 4096 + lane * 16;
            const char* pq_q = (const char*)(QACC + (size_t)(h * SCAN_G) * 4096) + dw * 8192 + lane * 16;
#define DMA_PQ(gi_, slot) do { const int gi = (gi_) < g ? (gi_) : g - 1; \
            _Pragma("unroll") for (int k_ = 0; k_ < 4; ++k_) __builtin_amdgcn_global_load_lds((const unsigned*)(pq_p + (size_t)gi * 8192 + k_ * 1024), (LAS unsigned*)(ldsl + (slot) * 24576 + dw * 4096 + k_ * 1024), 16, 0, 0); \
            _Pragma("unroll") for (int k_ = 0; k_ < 8; ++k_) __builtin_amdgcn_global_load_lds((const unsigned*)(pq_q + (size_t)gi * 16384 + k_ * 1024), (LAS unsigned*)(ldsl + (slot) * 24576 + 8192 + dw * 8192 + k_ * 1024), 16, 0, 0); } while (0)
            DMA_PQ(0, 0); DMA_PQ(1, 1); DMA_PQ(2, 2); DMA_PQ(3, 3);
            asm volatile("s_waitcnt vmcnt(36)" ::: "memory");
            SCAN_BAR();
            for (int gp = 0; gp < g; ++gp) {
                DMA_PQ(gp + 4, (gp + 4) % 5);
                asm volatile("s_waitcnt vmcnt(36)" ::: "memory");
                SCAN_BAR();
            }
            asm volatile("s_waitcnt vmcnt(0)" ::: "memory");
#undef DMA_PQ
        } }
        DMA_UNIT(0, 0); DMA_UNIT(1, 1); DMA_UNIT(2, 2);
        if constexpr (PASS1) asm volatile("s_waitcnt vmcnt(16)" ::: "memory"); else asm volatile("s_waitcnt vmcnt(32)" ::: "memory");
        SCAN_BAR();
        for (int n = 0; n < SCAN_L; ++n) {
            const int un = n + 3 < SCAN_L ? n + 3 : SCAN_L - 1;
            DMA_UNIT(un, (n + 3) & 3);
            if constexpr (PASS1) asm volatile("s_waitcnt vmcnt(16)" ::: "memory"); else asm volatile("s_waitcnt vmcnt(32)" ::: "memory");
            SCAN_BAR();
        }
        asm volatile("s_waitcnt vmcnt(0)" ::: "memory");
#undef DMA_UNIT
    } else {
        const int cgi = wave, l15 = lane & 15, gq = lane >> 4;
        const bf16_t* WBH = (const bf16_t*)(ws + WS_WB) + (size_t)(h * 256 + c0) * 4096 + cgi * 1024 + lane * 4;
        if (tid < SCAN_L) gll[tid] = GLp[tid];
        f32x4 S[4];
#pragma unroll
        for (int mb = 0; mb < 4; ++mb) S[mb] = (f32x4){0.f, 0.f, 0.f, 0.f};
        u32x2 W0[4], W1[4], W2[4], W3[4];
#define LDW(W, u_) do { const int uu_ = (u_) < SCAN_L ? (u_) : SCAN_L - 1; _Pragma("unroll") for (int mb = 0; mb < 4; ++mb) W[mb] = *(const u32x2*)(WBH + (size_t)uu_ * 4096 + mb * 256); } while (0)
        const int aoff0 = l15 * 128 + ((gq ^ (l15 >> 1)) << 4), aoff1 = l15 * 128 + (((4 + gq) ^ (l15 >> 1)) << 4);
#define AFR(mat, mb, s) (*(const bf16x8*)(sb + (mat) * 8192 + (mb) * 2048 + ((s) ? aoff1 : aoff0)))
        if constexpr (PASS1) {
            f32x4 T[4];
#pragma unroll
            for (int mb = 0; mb < 4; ++mb)
#pragma unroll
                for (int r = 0; r < 4; ++r) T[mb][r] = (16 * mb + 4 * gq + r == 16 * cgi + l15) ? 1.f : 0.f;
            LDW(W0, 0); ORDER_FENCE(); LDW(W1, 1); ORDER_FENCE(); LDW(W2, 2); ORDER_FENCE(); LDW(W3, 3); ORDER_FENCE();
            SCAN_BAR();
#define P1_STEP(W, n_) do { const int nq_ = (n_); \
            const unsigned char* sb = lds + (nq_ & 3) * 32768; const float glc = gll[nq_]; \
            bf16x8 Sb[2], Tb[2], Ub[2], Vb[2]; \
            _Pragma("unroll") for (int s = 0; s < 2; ++s) { Sb[s] = pack8(S[2 * s], S[2 * s + 1]); Tb[s] = pack8(T[2 * s], T[2 * s + 1]); } \
            f32x4 u[4], v[4]; \
            _Pragma("unroll") for (int mb = 0; mb < 4; ++mb) { const bf16x8 a0 = AFR(0, mb, 0), a1 = AFR(0, mb, 1); \
                u[mb] = (f32x4){bflo(W[mb].x), bfhi(W[mb].x), bflo(W[mb].y), bfhi(W[mb].y)}; v[mb] = (f32x4){0.f, 0.f, 0.f, 0.f}; \
                u[mb] = MFMA16(a0, Sb[0], u[mb]); v[mb] = MFMA16(a0, Tb[0], v[mb]); u[mb] = MFMA16(a1, Sb[1], u[mb]); v[mb] = MFMA16(a1, Tb[1], v[mb]); } \
            LDW(W, nq_ + 4); \
            _Pragma("unroll") for (int s = 0; s < 2; ++s) { Ub[s] = pack8(u[2 * s], u[2 * s + 1]); Vb[s] = pack8(v[2 * s], v[2 * s + 1]); } \
            _Pragma("unroll") for (int mb = 0; mb < 4; ++mb) { const bf16x8 a0 = AFR(3, mb, 0), a1 = AFR(3, mb, 1); S[mb] = S[mb] * glc; T[mb] = T[mb] * glc; \
                S[mb] = MFMA16(a0, Ub[0], S[mb]); T[mb] = MFMA16(a0, Vb[0], T[mb]); S[mb] = MFMA16(a1, Ub[1], S[mb]); T[mb] = MFMA16(a1, Vb[1], T[mb]); } \
            SCAN_BAR(); } while (0)
            for (int n = 0; n < SCAN_L; n += 4) { P1_STEP(W0, n); P1_STEP(W1, n + 1); P1_STEP(W2, n + 2); P1_STEP(W3, n + 3); }
#undef P1_STEP
            bf16_t* pim = PIMG + (size_t)(h * SCAN_G + g) * 4096; const int pj = permpos(16 * cgi + l15);
            float* qac = QACC + (size_t)(h * SCAN_G + g) * 4096 + cgi * 1024 + lane * 4;
#pragma unroll
            for (int mb = 0; mb < 4; ++mb) {
#pragma unroll
                for (int r = 0; r < 4; ++r) { const int d_ = 16 * mb + 4 * gq + r; pim[d_ * 64 + ((((pj >> 3) ^ (d_ >> 1)) & 7) << 3) + (pj & 7)] = (bf16_t)(pk2(T[mb][r], 0.f) & 0xffffu); }
                *(f32x4*)(qac + mb * 256) = S[mb]; }
        } else {
            LDW(W0, 0); ORDER_FENCE(); LDW(W1, 1); ORDER_FENCE(); LDW(W2, 2); ORDER_FENCE(); LDW(W3, 3); ORDER_FENCE();
            if (g > 0) {
                SCAN_BAR();
                for (int gp = 0; gp < g; ++gp) {
                    const unsigned char* sb = lds + (gp % 5) * 24576;
                    const bf16x8 s0 = pack8(S[0], S[1]), s1 = pack8(S[2], S[3]);
#pragma unroll
                    for (int mb = 0; mb < 4; ++mb) { const f32x4 q = *(const f32x4*)(sb + 8192 + (cgi * 1024 + mb * 256 + lane * 4) * 4);
                        f32x4 a = MFMA16(*(const bf16x8*)(sb + mb * 2048 + aoff0), s0, q); S[mb] = MFMA16(*(const bf16x8*)(sb + mb * 2048 + aoff1), s1, a); }
                    SCAN_BAR();
                }
            }
            SCAN_BAR();
#define SCAN_STEP(W, n_) do { const int nq_ = (n_); \
            const unsigned char* sb = lds + (nq_ & 3) * 32768; const float glc = gll[nq_]; \
            bf16x8 Sb[2], Ub[2]; \
            _Pragma("unroll") for (int s = 0; s < 2; ++s) Sb[s] = pack8(S[2 * s], S[2 * s + 1]); \
            f32x4 u[4], o[4]; \
            _Pragma("unroll") for (int mb = 0; mb < 4; ++mb) { u[mb] = (f32x4){bflo(W[mb].x), bfhi(W[mb].x), bflo(W[mb].y), bfhi(W[mb].y)}; \
                u[mb] = MFMA16(AFR(0, mb, 0), Sb[0], u[mb]); u[mb] = MFMA16(AFR(0, mb, 1), Sb[1], u[mb]); } \
            LDW(W, nq_ + 4); \
            _Pragma("unroll") for (int mb = 0; mb < 4; ++mb) { o[mb] = (f32x4){0.f, 0.f, 0.f, 0.f}; \
                o[mb] = MFMA16(AFR(1, mb, 0), Sb[0], o[mb]); o[mb] = MFMA16(AFR(1, mb, 1), Sb[1], o[mb]); } \
            _Pragma("unroll") for (int s = 0; s < 2; ++s) Ub[s] = pack8(u[2 * s], u[2 * s + 1]); \
            _Pragma("unroll") for (int mb = 0; mb < 4; ++mb) { S[mb] = S[mb] * glc; \
                S[mb] = MFMA16(AFR(3, mb, 0), Ub[0], S[mb]); S[mb] = MFMA16(AFR(3, mb, 1), Ub[1], S[mb]); } \
            _Pragma("unroll") for (int mb = 0; mb < 4; ++mb) { o[mb] = MFMA16(AFR(2, mb, 0), Ub[0], o[mb]); o[mb] = MFMA16(AFR(2, mb, 1), Ub[1], o[mb]); } \
            bf16_t* ob = obuf + (nq_ & 1) * 4608 + 16 * cgi + l15; \
            _Pragma("unroll") for (int mb = 0; mb < 4; ++mb) _Pragma("unroll") for (int r = 0; r < 4; ++r) ob[(16 * mb + 4 * gq + r) * 72] = (bf16_t)(pk2(o[mb][r], 0.f) & 0xffffu); \
            SCAN_BAR(); } while (0)
            for (int n = 0; n < SCAN_L; n += 4) { SCAN_STEP(W0, n); SCAN_STEP(W1, n + 1); SCAN_STEP(W2, n + 2); SCAN_STEP(W3, n + 3); }
#undef SCAN_STEP
        }
#undef AFR
#undef LDW
    }
}

DI void fox_attn_unit(const Params& P, int tid, int h, int qb, float PRUNE, int pir) {
    unsigned char* ws = P.ws;
    const int lane = tid & 63, wave = tid >> 6, r32 = lane & 31, hi = lane >> 5;
    const bf16_t* QN = (const bf16_t*)(ws + WS_PROJ) + 4 * BUF_ELEMS; const bf16_t* KN = (const bf16_t*)(ws + WS_PROJ) + 5 * BUF_ELEMS;
    const bf16_t* FZ = (const bf16_t*)(ws + WS_PROJ) + 7 * BUF_ELEMS; bf16_t* YB = (bf16_t*)(ws + WS_PROJ) + 1 * BUF_ELEMS;
    const bf16_t* VT = (const bf16_t*)(ws + WS_VT); const float* CL = (const float*)(ws + WS_CL); const float* CT = (const float*)(ws + WS_CT);
    (void)wave;
    const int t0 = qb * 32, nq = qb >> 1;
    const float* CLh = CL + (size_t)h * SEQ; const float* CTh = CT + h * 256;
    const bf16_t* KNh = KN + h * 64 + 8 * hi; const bf16_t* VTh = VT + (size_t)(h * 64 + r32) * SEQ + 8 * hi;
    bf16x8 qf[4];
#pragma unroll
    for (int ks = 0; ks < 4; ++ks) qf[ks] = *(const bf16x8*)(QN + (size_t)(t0 + r32) * 512 + h * 64 + 16 * ks + 8 * hi);
    const float cq = CLh[t0 + r32];
    const float cq0 = __uint_as_float(__builtin_amdgcn_readfirstlane(__float_as_uint(CLh[t0])));
    float offv; int nvalid;
    { const int cn = nq - 1 - lane; float pre = cn >= 0 ? CTh[cn] : 0.f;
#pragma unroll
      for (int o = 1; o < 64; o <<= 1) { const float up = __shfl_up(pre, o); if (lane >= o) pre += up; }
      const int kt = qb - 1 - lane, nk = kt >> 1, src = nq - 1 - nk;
      const float got = __shfl(pre, src < 0 ? 0 : src);
      offv = (kt >= 0 && src >= 0) ? got : 0.f;
      const float dmax = kt >= 0 ? cq0 + offv - CLh[32 * kt + 31] : -INFINITY;
      const unsigned long long stop = __ballot(dmax < -PRUNE || kt < 0);
      nvalid = stop ? (int)__builtin_ctzll(stop) : 64; }
    float mrun = -INFINITY, lsum = 0.f, offslow = 0.f;
    f32x16 oT[2];
#pragma unroll
    for (int i = 0; i < 16; ++i) { oT[0][i] = 0.f; oT[1][i] = 0.f; }
    bf16x8 kn_[4], vn_[2][2]; f32x4 cn_[4];
#define LOAD_TILE(k0_) do { const int kk0 = (k0_); \
        _Pragma("unroll") for (int ks = 0; ks < 4; ++ks) kn_[ks] = *(const bf16x8*)(KNh + (size_t)(kk0 + pir) * 512 + 16 * ks); \
        _Pragma("unroll") for (int blk = 0; blk < 2; ++blk) _Pragma("unroll") for (int s = 0; s < 2; ++s) vn_[blk][s] = *(const bf16x8*)(VTh + (size_t)(32 * blk) * SEQ + kk0 + 16 * s); \
        _Pragma("unroll") for (int s = 0; s < 2; ++s) { cn_[2 * s] = *(const f32x4*)(CLh + kk0 + 16 * s + 8 * hi); cn_[2 * s + 1] = *(const f32x4*)(CLh + kk0 + 16 * s + 8 * hi + 4); } } while (0)
    LOAD_TILE(t0);
    for (int kt = qb; kt >= 0; --kt) {
        float off = 0.f;
        if (kt != qb) {
            const int idx = qb - 1 - kt;
            if (idx < 64) { if (idx >= nvalid) break; off = __int_as_float(__builtin_amdgcn_readlane(__float_as_int(offv), idx)); offslow = off; }
            else {
                if (kt & 1) offslow += __uint_as_float(__builtin_amdgcn_readfirstlane(__float_as_uint(CTh[kt >> 1])));
                const float dmax = cq0 + offslow - __uint_as_float(__builtin_amdgcn_readfirstlane(__float_as_uint(CLh[32 * kt + 31])));
                if (dmax < -PRUNE) break;
                off = offslow; }
        }
        bf16x8 kf[4], vf[2][2]; f32x4 ck[4];
#pragma unroll
        for (int i = 0; i < 4; ++i) { kf[i] = kn_[i]; ck[i] = cn_[i]; }
        vf[0][0] = vn_[0][0]; vf[0][1] = vn_[0][1]; vf[1][0] = vn_[1][0]; vf[1][1] = vn_[1][1];
        if (kt > 0) LOAD_TILE(32 * (kt - 1));
        const float cb = cq + off;
        f32x16 sc;
#pragma unroll
        for (int i = 0; i < 16; ++i) sc[i] = cb;
#pragma unroll
        for (int ks = 0; ks < 4; ++ks) sc = MFMA32(kf[ks], qf[ks], sc);
        float mx = -INFINITY;
#pragma unroll
        for (int r = 0; r < 16; ++r) { const int kl = 16 * (r >> 3) + 8 * hi + (r & 7);
            float v = sc[r] - ck[r >> 2][r & 3];
            if (kt == qb && kl > r32) v = -INFINITY;
            sc[r] = v; mx = fmaxf(mx, v); }
        mx = fmaxf(mx, __shfl_xor(mx, 32));
        const float mnew = fmaxf(mrun, mx); const float alpha = __builtin_amdgcn_exp2f(mrun - mnew); mrun = mnew;
        float rs = 0.f;
#pragma unroll
        for (int r = 0; r < 16; ++r) { sc[r] = __builtin_amdgcn_exp2f(sc[r] - mnew); rs += sc[r]; }
        lsum = lsum * alpha + rs;
        if (__any(alpha != 1.0f)) {
#pragma unroll
            for (int i = 0; i < 16; ++i) { oT[0][i] *= alpha; oT[1][i] *= alpha; } }
        bf16x8 pb[2];
#pragma unroll
        for (int s = 0; s < 2; ++s) { u32x4 p; p.x = pk2(sc[8 * s], sc[8 * s + 1]); p.y = pk2(sc[8 * s + 2], sc[8 * s + 3]); p.z = pk2(sc[8 * s + 4], sc[8 * s + 5]); p.w = pk2(sc[8 * s + 6], sc[8 * s + 7]); pb[s] = __builtin_bit_cast(bf16x8, p); }
#pragma unroll
        for (int blk = 0; blk < 2; ++blk) { oT[blk] = MFMA32(vf[blk][0], pb[0], oT[blk]); oT[blk] = MFMA32(vf[blk][1], pb[1], oT[blk]); }
    }
#undef LOAD_TILE
    lsum += __shfl_xor(lsum, 32);
    const float inv = 1.0f / lsum;
    float ss = 0.f;
#pragma unroll
    for (int i = 0; i < 16; ++i) { oT[0][i] *= inv; oT[1][i] *= inv; ss += oT[0][i] * oT[0][i] + oT[1][i] * oT[1][i]; }
    ss += __shfl_xor(ss, 32);
    const float rstd = rsqrtf(ss * (1.f / 64.f) + EPS);
    const size_t rowoff = (size_t)(t0 + r32) * 512 + h * 64;
#pragma unroll
    for (int blk = 0; blk < 2; ++blk)
#pragma unroll
        for (int gi = 0; gi < 4; ++gi) { const int d = 32 * blk + 8 * gi + 4 * hi;
            const u32x2 z = *(const u32x2*)(FZ + rowoff + d); const f32x4 w = *(const f32x4*)(P.in[11] + d);
            const float z0 = bflo(z.x), z1 = bfhi(z.x), z2 = bflo(z.y), z3 = bfhi(z.y);
            u32x2 o; o.x = pk2(oT[blk][4 * gi] * rstd * w.x * z0 * sigmf(z0), oT[blk][4 * gi + 1] * rstd * w.y * z1 * sigmf(z1));
            o.y = pk2(oT[blk][4 * gi + 2] * rstd * w.z * z2 * sigmf(z2), oT[blk][4 * gi + 3] * rstd * w.w * z3 * sigmf(z3));
            *(u32x2*)(YB + rowoff + d) = o; }
}

#define BLK_BAR() asm volatile("s_waitcnt lgkmcnt(0)\n\ts_barrier" ::: "memory")
DI void fox_attn_blk(const Params& P, unsigned char* lds, LAS unsigned char* ldsl, int tid, int G, float PRUNE, int pir) {
    unsigned char* ws = P.ws;
    const int lane = tid & 63, wave = tid >> 6, r32 = lane & 31, hi = lane >> 5;
    const bf16_t* QN = (const bf16_t*)(ws + WS_PROJ) + 4 * BUF_ELEMS; const bf16_t* KN = (const bf16_t*)(ws + WS_PROJ) + 5 * BUF_ELEMS;
    const bf16_t* FZ = (const bf16_t*)(ws + WS_PROJ) + 7 * BUF_ELEMS; bf16_t* YB = (bf16_t*)(ws + WS_PROJ) + 1 * BUF_ELEMS;
    const bf16_t* VT = (const bf16_t*)(ws + WS_VT); const float* CL = (const float*)(ws + WS_CL); const float* CT = (const float*)(ws + WS_CT);
    const int h = (int)blockIdx.x & 7, bi = (int)blockIdx.x >> 3, nbh = G >> 3;
    const float* CLh = CL + (size_t)h * SEQ; const float* CTh = CT + h * 256;
    volatile int* nvs = (volatile int*)(lds + 12 * 10240);
    const int wvu = __builtin_amdgcn_readfirstlane(wave);
    const bool isk = tid < 256; const int sr = isk ? tid >> 3 : (tid - 256) >> 2, sl = isk ? tid & 7 : (tid - 256) & 3;
    const int scn = isk ? (sl ^ ((sr >> 1) & 7)) : (sl ^ ((sr >> 2) & 3));
    const bf16_t* gsrc = isk ? KN + (size_t)sr * 512 + h * 64 + 8 * scn : VT + (size_t)(h * 64 + sr) * SEQ + 8 * scn;
    const size_t gstep = isk ? (size_t)32 * 512 : (size_t)32;
    const int koff = pir * 128, ksw = (pir >> 1) & 7, voff = 4096 + r32 * 64, vsw = (r32 >> 2) & 3;
    for (int grp = bi; grp < 64; grp += nbh) {
        const int QB0 = grp * 8, qb = QB0 + wave, t0 = qb * 32, nq = qb >> 1;
        bf16x8 qf[4];
#pragma unroll
        for (int ks = 0; ks < 4; ++ks) qf[ks] = *(const bf16x8*)(QN + (size_t)(t0 + r32) * 512 + h * 64 + 16 * ks + 8 * hi);
        const float cq = CLh[t0 + r32];
        const float cq0 = __uint_as_float(__builtin_amdgcn_readfirstlane(__float_as_uint(CLh[t0])));
        float offv; int nvalid;
        { const int cn = nq - 1 - lane; float pre = cn >= 0 ? CTh[cn] : 0.f;
          const int kt = qb - 1 - lane; const float clen = kt >= 0 ? CLh[32 * kt + 31] : 0.f;
#pragma unroll
          for (int o = 1; o < 64; o <<= 1) { const float up = __shfl_up(pre, o); if (lane >= o) pre += up; }
          const int nk = kt >> 1, src = nq - 1 - nk;
          const float got = __shfl(pre, src < 0 ? 0 : src);
          offv = (kt >= 0 && src >= 0) ? got : 0.f;
          const float dmax = kt >= 0 ? cq0 + offv - clen : -INFINITY;
          const unsigned long long stop = __ballot(dmax < -PRUNE || kt < 0);
          nvalid = stop ? (int)__builtin_ctzll(stop) : 64; }
        const size_t rowoff = (size_t)(t0 + r32) * 512 + h * 64;
        if (lane == 0) nvs[wave] = nvalid;
        BLK_BAR();
        int nvmax = 0;
#pragma unroll
        for (int w_ = 0; w_ < 8; ++w_) { const int v_ = nvs[w_]; nvmax = v_ > nvmax ? v_ : nvmax; }
        nvmax = __builtin_amdgcn_readfirstlane(nvmax);
        if (nvmax >= 56) {
            BLK_BAR();
            fox_attn_unit(P, tid, h, qb, PRUNE, pir);
            continue; }
#define DMA_TILE(kt_) do { const int ku_ = (kt_), kc_ = ku_ > 0 ? ku_ : 0, b_ = (ku_ + 120) % 12; \
            __builtin_amdgcn_global_load_lds((const unsigned*)(gsrc + (size_t)kc_ * gstep), (LAS unsigned*)(ldsl + b_ * 10240 + wvu * 1024), 16, 0, 0); \
            __builtin_amdgcn_global_load_lds((const unsigned*)(CLh + 32 * kc_ + lane), (LAS unsigned*)(ldsl + b_ * 10240 + 8192 + wvu * 256), 4, 0, 0); } while (0)
        for (int j_ = 0; j_ < 11; ++j_) DMA_TILE(QB0 + 7 - j_);
        asm volatile("s_waitcnt vmcnt(6)" ::: "memory");
        float mrun = -INFINITY, lsum = 0.f;
        f32x16 oT[2];
#pragma unroll
        for (int i = 0; i < 16; ++i) { oT[0][i] = 0.f; oT[1][i] = 0.f; }
        BLK_BAR();
        const bool stag = wvu >= 4; bool pend = false;
        f32x16 sc; bf16x8 vf[2][2]; float alpha = 1.f;
#pragma unroll
        for (int i = 0; i < 16; ++i) sc[i] = 0.f;
        vf[0][0] = vf[0][1] = vf[1][0] = vf[1][1] = (bf16x8){0, 0, 0, 0, 0, 0, 0, 0};
#define ATT_TAIL() do { float rs = 0.f; \
            _Pragma("unroll") for (int r = 0; r < 16; ++r) rs += sc[r]; \
            lsum = lsum * alpha + rs; \
            if (__any(alpha != 1.0f)) { _Pragma("unroll") for (int i = 0; i < 16; ++i) { oT[0][i] *= alpha; oT[1][i] *= alpha; } } \
            bf16x8 pb[2]; \
            _Pragma("unroll") for (int s = 0; s < 2; ++s) { u32x4 p; p.x = pk2(sc[8 * s], sc[8 * s + 1]); p.y = pk2(sc[8 * s + 2], sc[8 * s + 3]); p.z = pk2(sc[8 * s + 4], sc[8 * s + 5]); p.w = pk2(sc[8 * s + 6], sc[8 * s + 7]); pb[s] = __builtin_bit_cast(bf16x8, p); } \
            _Pragma("unroll") for (int blk = 0; blk < 2; ++blk) { oT[blk] = MFMA32(vf[blk][0], pb[0], oT[blk]); oT[blk] = MFMA32(vf[blk][1], pb[1], oT[blk]); } } while (0)
        for (int it = 0; it <= nvmax; ++it) {
            if (pend) { ATT_TAIL(); pend = false; }
            DMA_TILE(QB0 - it - 4);
            const int kt = qb - it;
            if (it <= nvalid) {
                const unsigned char* tb = lds + ((kt + 120) % 12) * 10240;
                const float off = it == 0 ? 0.f : __int_as_float(__builtin_amdgcn_readlane(__float_as_int(offv), it - 1));
                bf16x8 kf[4]; f32x4 ck[4];
#pragma unroll
                for (int ks = 0; ks < 4; ++ks) kf[ks] = *(const bf16x8*)(tb + koff + (((2 * ks + hi) ^ ksw) << 4));
#pragma unroll
                for (int blk = 0; blk < 2; ++blk)
#pragma unroll
                    for (int s = 0; s < 2; ++s) vf[blk][s] = *(const bf16x8*)(tb + voff + blk * 2048 + (((2 * s + hi) ^ vsw) << 4));
#pragma unroll
                for (int s = 0; s < 2; ++s) { ck[2 * s] = *(const f32x4*)(tb + 8192 + wvu * 256 + (16 * s + 8 * hi) * 4); ck[2 * s + 1] = *(const f32x4*)(tb + 8192 + wvu * 256 + (16 * s + 8 * hi) * 4 + 16); }
                const float cb = cq + off;
#pragma unroll
                for (int i = 0; i < 16; ++i) sc[i] = cb;
#pragma unroll
                for (int ks = 0; ks < 4; ++ks) sc = MFMA32(kf[ks], qf[ks], sc);
                float mx = -INFINITY;
#pragma unroll
                for (int r = 0; r < 16; ++r) { const int kl = 16 * (r >> 3) + 8 * hi + (r & 7);
                    float v = sc[r] - ck[r >> 2][r & 3];
                    if (kt == qb && kl > r32) v = -INFINITY;
                    sc[r] = v; mx = fmaxf(mx, v); }
                { const auto rr = __builtin_amdgcn_permlane32_swap(__float_as_uint(mx), __float_as_uint(mx), false, false);
                  mx = fmaxf(__uint_as_float(rr[0]), __uint_as_float(rr[1])); }
                const float mnew = fmaxf(mrun, mx); alpha = __builtin_amdgcn_exp2f(mrun - mnew); mrun = mnew;
#pragma unroll
                for (int r = 0; r < 16; ++r) sc[r] = __builtin_amdgcn_exp2f(sc[r] - mnew);
                if (stag) pend = true; else ATT_TAIL();
            }
            asm volatile("s_waitcnt vmcnt(6)" ::: "memory");
            BLK_BAR();
        }
        if (pend) { ATT_TAIL(); pend = false; }
#undef ATT_TAIL
#undef DMA_TILE
        { const auto rr = __builtin_amdgcn_permlane32_swap(__float_as_uint(lsum), __float_as_uint(lsum), false, false); lsum = __uint_as_float(rr[0]) + __uint_as_float(rr[1]); }
        const float inv = 1.0f / lsum;
        float ss = 0.f;
#pragma unroll
        for (int i = 0; i < 16; ++i) { oT[0][i] *= inv; oT[1][i] *= inv; ss += oT[0][i] * oT[0][i] + oT[1][i] * oT[1][i]; }
        { const auto rr = __builtin_amdgcn_permlane32_swap(__float_as_uint(ss), __float_as_uint(ss), false, false); ss = __uint_as_float(rr[0]) + __uint_as_float(rr[1]); }
        const float rstd = rsqrtf(ss * (1.f / 64.f) + EPS);
#pragma unroll
        for (int blk = 0; blk < 2; ++blk)
#pragma unroll
            for (int gi = 0; gi < 4; ++gi) { const int d = 32 * blk + 8 * gi + 4 * hi;
                const u32x2 z = *(const u32x2*)(FZ + rowoff + d); const f32x4 w = *(const f32x4*)(P.in[11] + d);
                const float z0 = bflo(z.x), z1 = bfhi(z.x), z2 = bflo(z.y), z3 = bfhi(z.y);
                u32x2 o; o.x = pk2(oT[blk][4 * gi] * rstd * w.x * z0 * sigmf(z0), oT[blk][4 * gi + 1] * rstd * w.y * z1 * sigmf(z1));
                o.y = pk2(oT[blk][4 * gi + 2] * rstd * w.z * z2 * sigmf(z2), oT[blk][4 * gi + 3] * rstd * w.w * z3 * sigmf(z3));
                *(u32x2*)(YB + rowoff + d) = o; }
    }
}

DI void fox_attn(const Params& P, unsigned char* lds, LAS unsigned char* ldsl, int tid, int G) {
    const int lane = tid & 63, wave = tid >> 6, r32 = lane & 31;
    const float bq = wave_max(fabsf(P.in[9][lane])), bk = wave_max(fabsf(P.in[10][lane]));
    const float PRUNE = (2.f * 8.f * bq * bk + 30.f) * 1.4426950408889634f;
    const int pir = (r32 & ~12) | ((r32 & 4) << 1) | ((r32 & 8) >> 1);
    if ((G & 7) == 0) { fox_attn_blk(P, lds, ldsl, tid, G, PRUNE, pir); return; }
    const int nwaves = G * 8, gw = (int)blockIdx.x * 8 + wave;
    for (int u = gw; u < 4096; u += nwaves) fox_attn_unit(P, tid, u & 7, u >> 3, PRUNE, pir);
}

#define XB_TMO      128
#define XB_XCNT(j)  (256  + 64 * (j))
#define XB_XSUB(j)  (1280 + 64 * (j))
#define XB_XGEN(j)  (2304 + 64 * (j))
#define XB_TOP      3328
#define XB_TOPGEN   3392
#define XCD_BAR_WORDS 3456
#define XB_SPIN_CAP (1u << 18)
__device__ __forceinline__ unsigned xb_ld(unsigned* p)              { return __hip_atomic_load(p, __ATOMIC_RELAXED, __HIP_MEMORY_SCOPE_AGENT); }
__device__ __forceinline__ unsigned xb_add(unsigned* p, unsigned v) { return __hip_atomic_fetch_add(p, v, __ATOMIC_RELAXED, __HIP_MEMORY_SCOPE_AGENT); }
__device__ __forceinline__ unsigned xb_xcc_id() { return (unsigned)__builtin_amdgcn_s_getreg((3 << 11) | 20) & 0xFu; }
#define XB_SPIN(cond, bar) do { unsigned _sp = 0; while (cond) { __builtin_amdgcn_s_sleep(1); \
    if ((++_sp & 255u) == 0u) { if (xb_ld(&(bar)[XB_TMO])) break; if (_sp > XB_SPIN_CAP) { atomicAdd(&(bar)[XB_TMO], 1u); break; } } } } while (0)
struct XcdBarrier { unsigned* bar; unsigned x; volatile LAS unsigned* st; };
__device__ __forceinline__ XcdBarrier xcd_barrier_post(unsigned* bar, volatile LAS unsigned* st) {
    XcdBarrier b; b.bar = bar; b.x = xb_xcc_id(); b.st = st;
    if (threadIdx.x == 0) (void)xb_add(&bar[XB_XCNT(b.x)], 1u);
    return b;
}
__device__ __forceinline__ void xcd_barrier_complete(unsigned* bar, unsigned x, unsigned& nloc, unsigned& nx) {
    const unsigned G = gridDim.x * gridDim.y * gridDim.z;
    unsigned sum, cnt, mine, sp = 0u;
    for (;;) {
        sum = 0u; cnt = 0u; mine = 0u;
#pragma unroll
        for (unsigned j = 0; j < 16; ++j) { const unsigned c = xb_ld(&bar[XB_XCNT(j)]); sum += c; cnt += (c > 0u) ? 1u : 0u; mine = (j == x) ? c : mine; }
        if (sum == G) break;
        __builtin_amdgcn_s_sleep(1);
        if ((++sp & 255u) == 0u) { if (xb_ld(&bar[XB_TMO])) break; if (sp > XB_SPIN_CAP) { atomicAdd(&bar[XB_TMO], 1u); break; } }
    }
    nloc = mine > 0u ? mine : 1u; nx = cnt > 0u ? cnt : 1u;
}
__device__ __forceinline__ void xcd_barrier(const XcdBarrier& b) {
    asm volatile("s_waitcnt vmcnt(0)" ::: "memory");
    __syncthreads();
    if (threadIdx.x == 0) {
        unsigned* bar = b.bar;
        __builtin_amdgcn_s_waitcnt(0);
        unsigned nloc = b.st[0], nx = b.st[1];
        if (nloc == 0u) { xcd_barrier_complete(bar, b.x, nloc, nx); b.st[0] = nloc; b.st[1] = nx; }
        const unsigned old = xb_add(&bar[XB_XSUB(b.x)], 1u);
        const unsigned gen = old / nloc;
        if (old + 1u == (gen + 1u) * nloc) {
            __builtin_amdgcn_fence(__ATOMIC_RELEASE, "agent");
            asm volatile("s_waitcnt vmcnt(0)" ::: "memory");
            const unsigned og = xb_add(&bar[XB_TOP], 1u);
            const unsigned tg = og / nx;
            if (og + 1u == (tg + 1u) * nx) xb_add(&bar[XB_TOPGEN], 1u);
            else XB_SPIN(xb_ld(&bar[XB_TOPGEN]) == tg, bar);
            __builtin_amdgcn_fence(__ATOMIC_ACQUIRE, "agent");
            xb_add(&bar[XB_XGEN(b.x)], 1u);
            asm volatile("s_waitcnt vmcnt(0)" ::: "memory");
        } else {
            XB_SPIN(xb_ld(&bar[XB_XGEN(b.x)]) == gen, bar);
            __builtin_amdgcn_fence(__ATOMIC_ACQUIRE, "agent");
            asm volatile("s_waitcnt vmcnt(0)" ::: "memory");
        }
    }
    __syncthreads();
}

__global__ void __launch_bounds__(512, 2) mega_fwd(Params P) {
    extern __shared__ __attribute__((aligned(16))) unsigned char lds[];
    cg::grid_group grid = cg::this_grid();
    const int tid = threadIdx.x, G = gridDim.x;
    unsigned char* ws = P.ws;
    LAS unsigned char* ldsl = (LAS unsigned char*)lds;
    volatile LAS unsigned* bst = (volatile LAS unsigned*)(ldsl + 151040);
    if (tid < 2) bst[tid] = 0u;
    __syncthreads();
    const XcdBarrier bar = xcd_barrier_post((unsigned*)(ws + WS_BAR), bst);

    phase0(P, lds, tid, G);
    if ((G & 7) == 0) xcd_barrier(bar); else grid.sync();

    { pg8::Gemm g{(const bf16_t*)(ws + WS_H), (const bf16_t*)(ws + WS_WIN), SEQ, NMAIN, 1024}; pg8::StaticOrder S; S.init(SEQ, NMAIN, G, (int)blockIdx.x);
      pg8::EpiSplitBf16 E{(bf16_t*)(ws + WS_PROJ), BUF_ELEMS};
      pg8::gemm_phase<pg8::EpiSplitBf16, pg8::StaticOrder, true, true>(ldsl, g, S, E);
      small_proj(P, lds, tid, G);
 }
    if ((G & 7) == 0) xcd_barrier(bar); else grid.sync();

    if (G == 256) {
      const int hb = (int)blockIdx.x & 7, gb = (int)blockIdx.x >> 3;
      { u32x4 raw[12]; float sbv = 0.f, sav = 0.f;
        gdn_load(P, (8 * gb) * 8 + hb, tid, raw, sbv, sav);
        for (int i = tid; i < 768; i += 512) { const int j = i / 192, r = i % 192; ((float*)(lds + 86016))[i] = P.in[4][j * 1536 + (r >> 6) * 512 + hb * 64 + (r & 63)]; }
        __syncthreads();
        for (int k = 0; k < 8; ++k) gdn_prep_unit(P, hb, 8 * gb + k, lds, tid, raw, sbv, sav, k < 7 ? (8 * gb + k + 1) * 8 + hb : -1, true); }
      __syncthreads();
      gdn_scan<true>(P, hb, gb, lds, ldsl, tid);
      __syncthreads();
      for (int n = blockIdx.x; n < 256; n += G) fox_prep_unit(P, n, lds, tid);
      if ((G & 7) == 0) xcd_barrier(bar); else grid.sync();
    } else {
      { u32x4 raw[12]; float sbv = 0.f, sav = 0.f;
        if ((int)blockIdx.x < 2048) gdn_load(P, (int)blockIdx.x, tid, raw, sbv, sav);
        for (int u = blockIdx.x; u < 2048; u += G) gdn_prep_unit(P, u & 7, u >> 3, lds, tid, raw, sbv, sav, u + G < 2048 ? u + G : -1);
        __syncthreads(); }
      for (int n = blockIdx.x; n < 256; n += G) fox_prep_unit(P, n, lds, tid);
      if ((G & 7) == 0) xcd_barrier(bar); else grid.sync();
      for (int u = blockIdx.x; u < 256; u += G) { gdn_scan<true>(P, u & 7, u >> 3, lds, ldsl, tid); __syncthreads(); }
      if ((G & 7) == 0) xcd_barrier(bar); else grid.sync();
    }
    for (int u = blockIdx.x; u < 256; u += G) { gdn_scan<false>(P, u & 7, u >> 3, lds, ldsl, tid); __syncthreads(); }
    fox_attn(P, lds, ldsl, tid, G);
    if ((G & 7) == 0) xcd_barrier(bar); else grid.sync();

    { pg8::StaticOrder S; S.init(SEQ, 1024, G, (int)blockIdx.x);
      bf16_t* Mo = (bf16_t*)(ws + WS_PROJ) + 2 * BUF_ELEMS;
      { pg8::Gemm g{(const bf16_t*)(ws + WS_PROJ), (const bf16_t*)(ws + WS_WUPA), SEQ, 1024, 512};
        pg8::EpiGate E{Mo, (const bf16_t*)(ws + WS_PROJ) + 8 * BUF_ELEMS, BUF_ELEMS, P.in[3], 0};
        pg8::gemm_phase<pg8::EpiGate, pg8::StaticOrder, true, true>(ldsl, g, S, E); }
      __syncthreads();
      { pg8::Gemm g{(const bf16_t*)(ws + WS_PROJ) + BUF_ELEMS, (const bf16_t*)(ws + WS_WUPB), SEQ, 1024, 512};
        pg8::EpiGate E{Mo, (const bf16_t*)(ws + WS_PROJ) + 10 * BUF_ELEMS, BUF_ELEMS, P.in[3] + 1024, 1};
        pg8::gemm_phase<pg8::EpiGate, pg8::StaticOrder, true, true>(ldsl, g, S, E); } }
    if ((G & 7) == 0) xcd_barrier(bar); else grid.sync();

    if (G == 256) {
      pg8::StaticOrder S; S.init(SEQ, 1024, G, (int)blockIdx.x);
      pg8::Gemm g{(const bf16_t*)(ws + WS_PROJ) + 2 * BUF_ELEMS, (const bf16_t*)(ws + WS_WOUT), SEQ, 1024, 1024};
      pg8::EpiResNorm E{P.in[0], P.out, P.in[15], (float*)(ws + WS_XB), (unsigned*)(ws + WS_PCNT), EPS};
      pg8::gemm_phase<pg8::EpiResNorm, pg8::StaticOrder, false, true>(ldsl, g, S, E);
    } else {
      { pg8::StaticOrder S; S.init(SEQ, 1024, G, (int)blockIdx.x);
        pg8::Gemm g{(const bf16_t*)(ws + WS_PROJ) + 2 * BUF_ELEMS, (const bf16_t*)(ws + WS_WOUT), SEQ, 1024, 1024};
        pg8::EpiRes E{P.in[0], P.out};
        pg8::gemm_phase<pg8::EpiRes, pg8::StaticOrder, true, true>(ldsl, g, S, E); }
      if ((G & 7) == 0) xcd_barrier(bar); else grid.sync();
      { const int lane = tid & 63, wave = tid >> 6, gw = blockIdx.x * 8 + wave, NGW = G * 8;
        const float* fw = P.in[15]; f32x4 wv[4];
#pragma unroll
        for (int j = 0; j < 4; ++j) wv[j] = *(const f32x4*)(fw + 4 * lane + 256 * j);
        for (int m = gw; m < SEQ; m += NGW) {
            f32x4* xr = (f32x4*)(P.out + (size_t)m * DM) + lane; f32x4 v[4]; float s = 0.f;
#pragma unroll
            for (int j = 0; j < 4; ++j) { v[j] = xr[64 * j]; s += (v[j].x * v[j].x + v[j].y * v[j].y) + (v[j].z * v[j].z + v[j].w * v[j].w); }
            const float rstd = rsqrtf(wave_sum(s) * (1.f / DM) + EPS);
#pragma unroll
            for (int j = 0; j < 4; ++j) xr[64 * j] = v[j] * rstd * wv[j];
        } }
    }
}

extern "C" void kernel_launch(void* const* d_in, const int* in_sizes, int n_in, void* d_out, int out_size, void* d_ws, size_t ws_size, hipStream_t stream) {
    static int grid = 0;
    if (grid == 0) {
        if (n_in != 16 || out_size != SEQ * DM || ws_size < WS_END) { fprintf(stderr, "kernel_launch: unexpected shapes (n_in %d out %d ws %zu)\n", n_in, out_size, ws_size); grid = -1; return; }
        int dev = 0, cus = 0, per_cu = 0;
        hipGetDevice(&dev); hipDeviceGetAttribute(&cus, hipDeviceAttributeMultiprocessorCount, dev);
        if (hipFuncSetAttribute((const void*)mega_fwd, hipFuncAttributeMaxDynamicSharedMemorySize, LDS_BYTES) != hipSuccess) { fprintf(stderr, "hipFuncSetAttribute failed\n"); grid = -1; return; }
        if (hipOccupancyMaxActiveBlocksPerMultiprocessor(&per_cu, (const void*)mega_fwd, 512, LDS_BYTES) != hipSuccess || per_cu < 1) { fprintf(stderr, "occupancy query failed (%d)\n", per_cu); grid = -1; return; }
        grid = cus;
        if (grid < 16) { grid = -1; return; }
    }
    if (grid < 0) return;
    if (hipMemsetAsync((char*)d_ws + WS_BAR, 0, 32768, stream) != hipSuccess) { fprintf(stderr, "memset failed\n"); return; }
    Params p{};
    for (int i = 0; i < 16; ++i) p.in[i] = (const float*)d_in[i];
    p.out = (float*)d_out; p.ws = (unsigned char*)d_ws;
    void* args[] = {&p};
    hipError_t e = hipLaunchCooperativeKernel((const void*)mega_fwd, dim3(grid), dim3(512), args, LDS_BYTES, stream);
    if (e != hipSuccess) fprintf(stderr, "cooperative launch failed: %s (grid %d)\n", hipGetErrorString(e), grid);
}
```

```cpp
#include <hip/hip_runtime.h>
#include <hip/hip_cooperative_groups.h>
#include <cstdio>
#include <cstdint>
namespace cg = cooperative_groups;

#define DI __device__ __forceinline__
namespace pg8 {
#define PG8_LAS __attribute__((address_space(3)))
typedef unsigned short bf16_t;
typedef short bf16x8 __attribute__((ext_vector_type(8)));
typedef float f32x4 __attribute__((ext_vector_type(4)));
typedef unsigned u32x4 __attribute__((ext_vector_type(4)));
constexpr int BM = 256, BK = 64, HALF = 128, HTB = HALF * BK * 2, STAGE_BYTES = 8 * HTB, NXCD = 8, WGM = 8;

__host__ __device__ __forceinline__ int lds_byte(int r, int c) { const int st = (r >> 4) * 2 + (c >> 5), rr = r & 15, cc = c & 31, ob = rr * 64 + cc * 2; return st * 1024 + (ob ^ (((ob >> 9) & 1) << 5)); }
__host__ __device__ __forceinline__ void stage_rc(int b, int& R, int& C) { const int st = b / 1024, sb = b % 1024, swz = sb ^ (((sb >> 9) & 1) << 5); R = (st >> 1) * 16 + swz / 64; C = (st & 1) * 32 + (swz % 64) / 2; }
__host__ __device__ __forceinline__ int perm32(int rho) { const int n = rho >> 4, i = rho & 15; return 8 * (i >> 2) + 4 * n + (i & 3); }

struct Unit { int pm, pn; };
struct Gemm { const bf16_t* A; const bf16_t* Bt; int M, N, K; };

struct StaticOrder {
    int nM, nN, nwg, G, c;
    __host__ __device__ void init(int M, int N, int G_, int c_) { nM = M / BM; nN = N / BM; nwg = nM * nN; G = G_; c = c_; }
    __host__ __device__ bool next(int i, Unit& u) const {
        const long L = (long)i * G + c; if (L >= nwg) return false;
        int wgid = (int)L; { const int q = nwg / NXCD, r = nwg % NXCD, xcd = wgid % NXCD, off = wgid / NXCD; wgid = (xcd < r ? xcd * (q + 1) : r * (q + 1) + (xcd - r) * q) + off; }
        const int nig = WGM * nN, gid = wgid / nig, fm = gid * WGM, gsz = (nM - fm) < WGM ? (nM - fm) : WGM;
        u.pm = fm + ((wgid % nig) % gsz); u.pn = (wgid % nig) / gsz; return true;
    }
    __device__ __forceinline__ void a_ready(const Unit&) const {}
    __device__ __forceinline__ void done(const Unit&) const {}
};

__device__ __forceinline__ unsigned cvt_pk_bf16(float lo, float hi) { unsigned r; asm volatile("v_cvt_pk_bf16_f32 %0, %1, %2" : "=v"(r) : "v"(lo), "v"(hi)); return r; }
__device__ __forceinline__ float bflo(unsigned u) { return __uint_as_float(u << 16); }
__device__ __forceinline__ float bfhi(unsigned u) { return __uint_as_float(u & 0xffff0000u); }
__device__ __forceinline__ float sigm(float v) { return __builtin_amdgcn_rcpf(1.0f + __expf(-v)); }

struct EpiSplitBf16 {
    static constexpr bool PERM = true, AFTER_DRAIN = false;
    bf16_t* O; size_t split_stride;
    __device__ __forceinline__ void operator()(const f32x4 (&acc)[2][2][4][2], const Unit& u, int wr, int wc, int fr, int fq) const {
        const int row0 = u.pm * BM + wr * 64 + fr; int colt = u.pn * BM; const int t = colt / 512; bf16_t* base = O + (size_t)t * split_stride; colt -= t * 512;
        const int col0 = colt + wc * 32 + 8 * fq;
#pragma unroll
        for (int ai = 0; ai < 2; ++ai)
#pragma unroll
            for (int m = 0; m < 4; ++m) { bf16_t* rowp = base + (size_t)(row0 + ai * HALF + m * 16) * 512 + col0;
#pragma unroll
                for (int bj = 0; bj < 2; ++bj) { const f32x4 v0 = acc[ai][bj][m][0], v1 = acc[ai][bj][m][1];
                    u32x4 w; w.x = cvt_pk_bf16(v0[0], v0[1]); w.y = cvt_pk_bf16(v0[2], v0[3]); w.z = cvt_pk_bf16(v1[0], v1[1]); w.w = cvt_pk_bf16(v1[2], v1[3]);
                    *(u32x4*)(rowp + bj * HALF) = w; } }
    }
};
struct EpiGate {
    static constexpr bool PERM = true, AFTER_DRAIN = false;
    bf16_t* Mo; const bf16_t* G0; size_t split_stride; const float* gb; int accum;
    __device__ __forceinline__ void operator()(const f32x4 (&acc)[2][2][4][2], const Unit& u, int wr, int wc, int fr, int fq) const {
        const int row0 = u.pm * BM + wr * 64 + fr; const int colt = u.pn * BM; const int t = colt / 512;
        const bf16_t* gbase = G0 + (size_t)t * split_stride; const int col0 = colt + wc * 32 + 8 * fq, gcol0 = col0 - t * 512;
#pragma unroll
        for (int bj = 0; bj < 2; ++bj) {
            const f32x4 b0 = *(const f32x4*)(gb + col0 + bj * HALF), b1 = *(const f32x4*)(gb + col0 + bj * HALF + 4);
#pragma unroll
            for (int ai = 0; ai < 2; ++ai)
#pragma unroll
                for (int m = 0; m < 4; ++m) { const size_t row = (size_t)(row0 + ai * HALF + m * 16);
                    const u32x4 g = *(const u32x4*)(gbase + row * 512 + gcol0 + bj * HALF);
                    const f32x4 v0 = acc[ai][bj][m][0], v1 = acc[ai][bj][m][1];
                    float r0 = v0[0] * sigm(bflo(g.x) + b0[0]), r1 = v0[1] * sigm(bfhi(g.x) + b0[1]), r2 = v0[2] * sigm(bflo(g.y) + b0[2]), r3 = v0[3] * sigm(bfhi(g.y) + b0[3]);
                    float r4 = v1[0] * sigm(bflo(g.z) + b1[0]), r5 = v1[1] * sigm(bfhi(g.z) + b1[1]), r6 = v1[2] * sigm(bflo(g.w) + b1[2]), r7 = v1[3] * sigm(bfhi(g.w) + b1[3]);
                    bf16_t* op = Mo + row * 1024 + col0 + bj * HALF;
                    if (accum) { const u32x4 p = *(const u32x4*)op; r0 += bflo(p.x); r1 += bfhi(p.x); r2 += bflo(p.y); r3 += bfhi(p.y); r4 += bflo(p.z); r5 += bfhi(p.z); r6 += bflo(p.w); r7 += bfhi(p.w); }
                    u32x4 w; w.x = cvt_pk_bf16(r0, r1); w.y = cvt_pk_bf16(r2, r3); w.z = cvt_pk_bf16(r4, r5); w.w = cvt_pk_bf16(r6, r7);
                    *(u32x4*)op = w; }
        }
    }
};
struct EpiRes {
    static constexpr bool PERM = false, AFTER_DRAIN = false;
    const float* base; float* out;
    __device__ __forceinline__ void operator()(const f32x4 (&acc)[2][2][4][2], const Unit& u, int wr, int wc, int fr, int fq) const {
        const int col0 = u.pn * BM + wc * 32 + 4 * fq;
#pragma unroll
        for (int ai = 0; ai < 2; ++ai)
#pragma unroll
            for (int m = 0; m < 4; ++m) { const size_t off = (size_t)(u.pm * BM + ai * HALF + wr * 64 + m * 16 + fr) * 1024 + col0;
#pragma unroll
                for (int bj = 0; bj < 2; ++bj)
#pragma unroll
                    for (int n = 0; n < 2; ++n) { const f32x4 bs = *(const f32x4*)(base + off + bj * HALF + n * 16); *(f32x4*)(out + off + bj * HALF + n * 16) = bs + acc[ai][bj][m][n]; } }
    }
};

struct EpiResNorm {
    static constexpr bool PERM = false, AFTER_DRAIN = true;
    const float* base; float* out; const float* fw; float* xbuf; unsigned* cnt; float eps;
    __device__ __forceinline__ void fused(f32x4 (&acc)[2][2][4][2], const Unit& u, int wr, int wc, int fr, int fq, PG8_LAS unsigned char* lds, int wid, int lane) const {
        PG8_LAS float* Pp = (PG8_LAS float*)lds;
        PG8_LAS float* Sr = (PG8_LAS float*)(lds + 4096);
        const int col0 = u.pn * BM + wc * 32 + 4 * fq;
#pragma unroll
        for (int ai = 0; ai < 2; ++ai)
#pragma unroll
            for (int m = 0; m < 4; ++m) { const int rl = ai * HALF + wr * 64 + m * 16 + fr; const size_t off = (size_t)(u.pm * BM + rl) * 1024 + col0; float s = 0.f;
#pragma unroll
                for (int bj = 0; bj < 2; ++bj)
#pragma unroll
                    for (int n = 0; n < 2; ++n) { const f32x4 xv = *(const f32x4*)(base + off + bj * HALF + n * 16); f32x4 v = acc[ai][bj][m][n] + xv; acc[ai][bj][m][n] = v;
                        s += (v[0] * v[0] + v[1] * v[1]) + (v[2] * v[2] + v[3] * v[3]); }
                s += __shfl_xor(s, 16); s += __shfl_xor(s, 32);
                if (fq == 0) Pp[rl * 4 + wc] = s; }
        asm volatile("s_waitcnt lgkmcnt(0)" ::: "memory"); __builtin_amdgcn_s_barrier(); asm volatile("" ::: "memory");
        const int row = wid * 32 + (lane & 31);
        if (lane < 32) { const float tot = (Pp[row * 4 + 0] + Pp[row * 4 + 1]) + (Pp[row * 4 + 2] + Pp[row * 4 + 3]);
            __hip_atomic_store(xbuf + (size_t)(u.pm * BM + row) * 4 + u.pn, tot, __ATOMIC_RELAXED, __HIP_MEMORY_SCOPE_AGENT); }
        asm volatile("s_waitcnt vmcnt(0)" ::: "memory");
        if (lane == 0) __hip_atomic_fetch_add(cnt + 64 * u.pm, 1u, __ATOMIC_RELAXED, __HIP_MEMORY_SCOPE_AGENT);
        if (wid == 0) {
            unsigned sp = 0;
            for (;;) { if ((unsigned)__builtin_amdgcn_readfirstlane(__hip_atomic_load(cnt + 64 * u.pm, __ATOMIC_RELAXED, __HIP_MEMORY_SCOPE_AGENT)) >= 32u) break;
                if (++sp > (1u << 20)) break; __builtin_amdgcn_s_sleep(2); }
            __builtin_amdgcn_fence(__ATOMIC_ACQUIRE, "agent");
        }
        asm volatile("s_waitcnt vmcnt(0) lgkmcnt(0)" ::: "memory"); __builtin_amdgcn_s_barrier(); asm volatile("" ::: "memory");
        if (lane < 32) { const float* slot = xbuf + (size_t)(u.pm * BM + row) * 4; float tot = 0.f;
#pragma unroll
            for (int t = 0; t < 4; ++t) tot += __hip_atomic_load(slot + t, __ATOMIC_RELAXED, __HIP_MEMORY_SCOPE_AGENT);
            Sr[row] = rsqrtf(tot * (1.0f / 1024.0f) + eps); }
        asm volatile("s_waitcnt lgkmcnt(0)" ::: "memory"); __builtin_amdgcn_s_barrier(); asm volatile("" ::: "memory");
#pragma unroll
        for (int bj = 0; bj < 2; ++bj)
#pragma unroll
            for (int n = 0; n < 2; ++n) { const f32x4 w4 = *(const f32x4*)(fw + col0 + bj * HALF + n * 16);
#pragma unroll
                for (int ai = 0; ai < 2; ++ai)
#pragma unroll
                    for (int m = 0; m < 4; ++m) { const int rl = ai * HALF + wr * 64 + m * 16 + fr; const float rs = Sr[rl];
                        *(f32x4*)(out + (size_t)(u.pm * BM + rl) * 1024 + col0 + bj * HALF + n * 16) = acc[ai][bj][m][n] * rs * w4; } }
    }
};

template <class Epi, class Sched, bool ALIGN_EPI = false, bool SP2 = false>
__device__ __forceinline__ void gemm_phase(PG8_LAS unsigned char* lds, const Gemm g, const Sched& S, const Epi& E) {
    int tid_ = threadIdx.x; asm volatile("" : "+v"(tid_));
    const int tid = tid_, wid = __builtin_amdgcn_readfirstlane(tid >> 6), lane = tid & 63, wr = wid >> 2, wc = wid & 3, fr = lane & 15, fq = lane >> 4;
    const int K = g.K, nt = K / BK;
    unsigned voffA[2], voffB[2];
#pragma unroll
    for (int i = 0; i < 2; ++i) { int R, C; stage_rc(tid * 16 + i * 8192, R, C); const int Rb = Epi::PERM ? ((R & ~31) + perm32(R & 31)) : R;
        voffA[i] = (unsigned)(R * K + C) * 2u; voffB[i] = (unsigned)(Rb * K + C) * 2u; }
    const size_t kstep = (size_t)(BK * 2);
    const size_t hstep = (size_t)HALF * K * 2;
    const size_t tstep = 2 * hstep;
    const unsigned ldsw = (unsigned)wid * 1024u;
    const int aoff = lds_byte(wr * 64 + fr, fq * 8), boff = lds_byte(wc * 32 + fr, fq * 8);
#define PG8_SA(b, h) (((b) * 2 + (h)) * HTB)
#define PG8_SB(b, h) ((4 + (b) * 2 + (h)) * HTB)
#define PG8_STAGE(bufoff, gbase, voff) do { _Pragma("unroll") for (int _i = 0; _i < 2; ++_i) \
        __builtin_amdgcn_global_load_lds((const unsigned*)((const char*)(gbase) + (voff)[_i]), (PG8_LAS unsigned*)(lds + (bufoff) + ldsw + _i * 8192), 16, 0, 0); } while (0)
#define PG8_LDA(dst, b, h) do { _Pragma("unroll") for (int m = 0; m < 4; ++m) _Pragma("unroll") for (int k = 0; k < 2; ++k) dst[m][k] = *(const PG8_LAS bf16x8*)(lds + PG8_SA(b, h) + aoff + m * 2048 + k * 1024); } while (0)
#define PG8_LDB(dst, b, h) do { _Pragma("unroll") for (int n = 0; n < 2; ++n) _Pragma("unroll") for (int k = 0; k < 2; ++k) dst[n][k] = *(const PG8_LAS bf16x8*)(lds + PG8_SB(b, h) + boff + n * 2048 + k * 1024); } while (0)
#define PG8_MMA(ai, bj, At, Bt) do { __builtin_amdgcn_s_setprio(1); _Pragma("unroll") for (int m = 0; m < 4; ++m) _Pragma("unroll") for (int n = 0; n < 2; ++n) _Pragma("unroll") for (int k = 0; k < 2; ++k) \
        acc[ai][bj][m][n] = __builtin_amdgcn_mfma_f32_16x16x32_bf16(Bt[n][k], At[m][k], acc[ai][bj][m][n], 0, 0, 0); __builtin_amdgcn_s_setprio(0); } while (0)
#define PG8_WAIT_V(n) asm volatile("s_waitcnt vmcnt(" #n ")" ::: "memory")
#define PG8_WAIT_L(n) asm volatile("s_waitcnt lgkmcnt(" #n ")" ::: "memory")
#define PG8_BAR __builtin_amdgcn_s_barrier()
#define PG8_SCHED __builtin_amdgcn_sched_barrier(0)
    Unit cur, nxt; int ui = 0;
    if (!S.next(0, cur)) return;
    f32x4 acc[2][2][4][2];
#pragma unroll
    for (int a = 0; a < 2; ++a)
#pragma unroll
        for (int b = 0; b < 2; ++b)
#pragma unroll
            for (int m = 0; m < 4; ++m)
#pragma unroll
                for (int n = 0; n < 2; ++n) acc[a][b][m][n] = (f32x4){0.f, 0.f, 0.f, 0.f};
    bf16x8 At[4][2], B0[2][2], B1[2][2];
    const char* cA = (const char*)g.A + (size_t)cur.pm * tstep; const char* cB = (const char*)g.Bt + (size_t)cur.pn * tstep;
    S.a_ready(cur);
    if constexpr (SP2) {
        PG8_STAGE(PG8_SB(0, 0), cB, voffB); PG8_STAGE(PG8_SB(0, 1), cB + hstep, voffB); PG8_STAGE(PG8_SA(0, 0), cA, voffA); PG8_STAGE(PG8_SA(0, 1), cA + hstep, voffA);
        if (wr == 1) PG8_BAR;
        PG8_WAIT_V(2); PG8_BAR;
        PG8_STAGE(PG8_SB(1, 0), cB + kstep, voffB); PG8_STAGE(PG8_SA(1, 0), cA + kstep, voffA); PG8_STAGE(PG8_SB(1, 1), cB + hstep + kstep, voffB);
        PG8_WAIT_V(6); PG8_BAR;
    } else {
        PG8_STAGE(PG8_SB(0, 0), cB, voffB); PG8_STAGE(PG8_SA(0, 0), cA, voffA); PG8_STAGE(PG8_SB(0, 1), cB + hstep, voffB); PG8_STAGE(PG8_SA(0, 1), cA + hstep, voffA);
        if (wr == 1) PG8_BAR;
        PG8_WAIT_V(4); PG8_BAR;
        PG8_STAGE(PG8_SB(1, 0), cB + kstep, voffB); PG8_STAGE(PG8_SA(1, 0), cA + kstep, voffA); PG8_STAGE(PG8_SB(1, 1), cB + hstep + kstep, voffB);
        PG8_WAIT_V(6); PG8_BAR;
    }
    for (;;) {
        const bool has_next = S.next(ui + 1, nxt);
        const char* nA = has_next ? (const char*)g.A + (size_t)nxt.pm * tstep : cA; const char* nB = has_next ? (const char*)g.Bt + (size_t)nxt.pn * tstep : cB;
        for (int t = 0; t < nt; t += 2) {
            const bool last = (t == nt - 2);
            const char* a1 = cA + (size_t)(t + 1) * kstep;
            const char* a2 = last ? nA : cA + (size_t)(t + 2) * kstep; const char* b2 = last ? nB : cB + (size_t)(t + 2) * kstep;
            const char* a3 = a2 + kstep; const char* b3 = b2 + kstep;
            if (last && has_next) S.a_ready(nxt);
            if constexpr (SP2) {
            PG8_LDB(B0, 0, 0); PG8_LDB(B1, 0, 1); PG8_SCHED; PG8_LDA(At, 0, 0); PG8_STAGE(PG8_SA(1, 1), a1 + hstep, voffA);
            PG8_WAIT_V(8); PG8_WAIT_L(0); PG8_BAR; PG8_MMA(0, 0, At, B0); PG8_MMA(0, 1, At, B1); PG8_BAR; PG8_SCHED;
            PG8_LDA(At, 0, 1); PG8_STAGE(PG8_SB(0, 0), b2, voffB); PG8_STAGE(PG8_SB(0, 1), b2 + hstep, voffB); PG8_STAGE(PG8_SA(0, 0), a2, voffA);
            PG8_WAIT_V(8); PG8_WAIT_L(0); PG8_BAR; PG8_MMA(1, 0, At, B0); PG8_MMA(1, 1, At, B1); PG8_BAR; PG8_SCHED;
            PG8_LDB(B0, 1, 0); PG8_LDB(B1, 1, 1); PG8_SCHED; PG8_LDA(At, 1, 0); PG8_STAGE(PG8_SA(0, 1), a2 + hstep, voffA);
            PG8_WAIT_V(8); PG8_WAIT_L(0); PG8_BAR; PG8_MMA(0, 0, At, B0); PG8_MMA(0, 1, At, B1); PG8_BAR; PG8_SCHED;
            PG8_LDA(At, 1, 1); PG8_STAGE(PG8_SB(1, 0), b3, voffB); PG8_STAGE(PG8_SB(1, 1), b3 + hstep, voffB); PG8_STAGE(PG8_SA(1, 0), a3, voffA);
            PG8_WAIT_V(8); PG8_WAIT_L(0); PG8_BAR; PG8_MMA(1, 0, At, B0); PG8_MMA(1, 1, At, B1); PG8_BAR; PG8_SCHED;
            } else {
            PG8_LDB(B0, 0, 0); PG8_SCHED; PG8_LDA(At, 0, 0); PG8_STAGE(PG8_SA(1, 1), a1 + hstep, voffA);
            PG8_WAIT_L(8); PG8_BAR; PG8_WAIT_L(0); PG8_MMA(0, 0, At, B0); PG8_BAR; PG8_SCHED;
            PG8_LDB(B1, 0, 1); PG8_STAGE(PG8_SB(0, 0), b2, voffB);
            PG8_BAR; PG8_WAIT_L(0); PG8_MMA(0, 1, At, B1); PG8_BAR;
            PG8_LDA(At, 0, 1); PG8_STAGE(PG8_SA(0, 0), a2, voffA);
            PG8_BAR; PG8_WAIT_L(0); PG8_MMA(1, 0, At, B0); PG8_BAR; PG8_SCHED;
            PG8_STAGE(PG8_SB(0, 1), b2 + hstep, voffB);
            PG8_WAIT_V(6); PG8_BAR; PG8_MMA(1, 1, At, B1); PG8_BAR;
            PG8_LDB(B0, 1, 0); PG8_SCHED; PG8_LDA(At, 1, 0); PG8_STAGE(PG8_SA(0, 1), a2 + hstep, voffA);
            PG8_WAIT_L(8); PG8_BAR; PG8_WAIT_L(0); PG8_MMA(0, 0, At, B0); PG8_BAR; PG8_SCHED;
            PG8_LDB(B1, 1, 1); PG8_STAGE(PG8_SB(1, 0), b3, voffB);
            PG8_BAR; PG8_WAIT_L(0); PG8_MMA(0, 1, At, B1); PG8_BAR;
            PG8_LDA(At, 1, 1); PG8_STAGE(PG8_SA(1, 0), a3, voffA);
            PG8_BAR; PG8_WAIT_L(0); PG8_MMA(1, 0, At, B0); PG8_BAR; PG8_SCHED;
            PG8_STAGE(PG8_SB(1, 1), b3 + hstep, voffB);
            PG8_WAIT_V(6); PG8_BAR; PG8_MMA(1, 1, At, B1); PG8_BAR;
            }
        }
        if constexpr (ALIGN_EPI) { if (wr == 0) PG8_BAR; }
        if constexpr (!Epi::AFTER_DRAIN) { E(acc, cur, wr, wc, fr, fq); S.done(cur); }
        if (!has_next) break;
#pragma unroll
        for (int a = 0; a < 2; ++a)
#pragma unroll
            for (int b = 0; b < 2; ++b)
#pragma unroll
                for (int m = 0; m < 4; ++m)
#pragma unroll
                    for (int n = 0; n < 2; ++n) acc[a][b][m][n] = (f32x4){0.f, 0.f, 0.f, 0.f};
        cur = nxt; cA = nA; cB = nB; ++ui;
        if constexpr (ALIGN_EPI) { if (wr == 1) PG8_BAR; }
    }
    PG8_WAIT_V(0);
    if constexpr (!ALIGN_EPI) { if (wr == 0) PG8_BAR; }
    PG8_BAR;
    if constexpr (Epi::AFTER_DRAIN) { E.fused(acc, cur, wr, wc, fr, fq, lds, wid, lane); }
#undef PG8_SA
#undef PG8_SB
#undef PG8_STAGE
#undef PG8_LDA
#undef PG8_LDB
#undef PG8_MMA
#undef PG8_WAIT_V
#undef PG8_WAIT_L
#undef PG8_BAR
#undef PG8_SCHED
}
}

typedef unsigned short bf16_t;
typedef short bf16x8 __attribute__((ext_vector_type(8)));
typedef float f32x4 __attribute__((ext_vector_type(4)));
typedef float f32x16 __attribute__((ext_vector_type(16)));
typedef unsigned u32x4 __attribute__((ext_vector_type(4)));
typedef unsigned u32x2 __attribute__((ext_vector_type(2)));
#define LAS __attribute__((address_space(3)))

constexpr int SEQ = 16384, DM = 1024, DIN = 6168, NMAIN = 6144;
constexpr float EPS = 1e-6f;
constexpr size_t MiB = 1u << 20;
constexpr size_t WS_CT = 0;
constexpr size_t WS_GL = 64 * 1024;
constexpr size_t WS_BAR = 128 * 1024;
constexpr size_t WS_PCNT = 144 * 1024;
constexpr size_t WS_XB = 256 * 1024;
constexpr size_t WS_SMALL = 1 * MiB;
constexpr size_t WS_CL = 3 * MiB;
constexpr size_t WS_WSM = 4 * MiB;
constexpr size_t WS_WUPA = 5 * MiB, WS_WUPB = 6 * MiB, WS_WOUT = 7 * MiB, WS_WIN = 9 * MiB;
constexpr size_t WS_H = 21 * MiB;
constexpr size_t WS_WB = WS_H, WS_VT = WS_H + 16 * MiB;
constexpr size_t WS_PROJ = 53 * MiB;
constexpr size_t BUF_ELEMS = (size_t)SEQ * 512;
constexpr size_t WS_PG = 246 * MiB;
constexpr size_t WS_QG = 248 * MiB;
constexpr size_t WS_END = 252 * MiB;
constexpr int LDS_BYTES = 151552;

struct Params { const float* in[16]; float* out; unsigned char* ws; };

DI float bflo(unsigned u) { return __uint_as_float(u << 16); }
DI float bfhi(unsigned u) { return __uint_as_float(u & 0xffff0000u); }
DI float bf2f(bf16_t v) { return __uint_as_float(((unsigned)v) << 16); }
typedef float f32x2_t __attribute__((ext_vector_type(2))); typedef __bf16 bf16x2_t __attribute__((ext_vector_type(2)));
DI unsigned pk2(float lo, float hi) { f32x2_t v = {lo, hi}; bf16x2_t b = __builtin_convertvector(v, bf16x2_t); return __builtin_bit_cast(unsigned, b); }
DI float wave_sum(float v) {
#pragma unroll
    for (int o = 1; o < 64; o <<= 1) v += __shfl_xor(v, o);
    return v;
}
DI float wave_max(float v) {
#pragma unroll
    for (int o = 1; o < 64; o <<= 1) v = fmaxf(v, __shfl_xor(v, o));
    return v;
}
DI float dpp_xor1(float v) { return __int_as_float(__builtin_amdgcn_update_dpp(0, __float_as_int(v), 0xB1, 0xf, 0xf, false)); }
DI float dpp_xor2(float v) { return __int_as_float(__builtin_amdgcn_update_dpp(0, __float_as_int(v), 0x4E, 0xf, 0xf, false)); }
DI float dpp_half_mirror(float v) { return __int_as_float(__builtin_amdgcn_update_dpp(0, __float_as_int(v), 0x141, 0xf, 0xf, false)); }
DI float wave_incl_scan(float v) {
#define SCAN_DPP(ctrl, rmask) v += __int_as_float(__builtin_amdgcn_update_dpp(0, __float_as_int(v), ctrl, rmask, 0xf, false))
    SCAN_DPP(0x111, 0xf); SCAN_DPP(0x112, 0xf); SCAN_DPP(0x114, 0xf); SCAN_DPP(0x118, 0xf); SCAN_DPP(0x142, 0xa); SCAN_DPP(0x143, 0xc);
#undef SCAN_DPP
    return v;
}
DI float sigmf(float v) { return __builtin_amdgcn_rcpf(1.0f + __expf(-v)); }
DI float softplusf(float v) { return v > 20.f ? v : __logf(1.0f + __expf(v)); }
#define MFMA16(a, b, c) __builtin_amdgcn_mfma_f32_16x16x32_bf16((a), (b), (c), 0, 0, 0)
#define MFMA32(a, b, c) __builtin_amdgcn_mfma_f32_32x32x16_bf16((a), (b), (c), 0, 0, 0)
#define LDSFENCE() asm volatile("s_waitcnt lgkmcnt(0)" ::: "memory")

DI void p0_transpose_item(const float* W, int ldN, int srccol, bf16_t* WT, int K, int destrow, int k0, float* scr, int lane) {
    float tv[32];
#pragma unroll
    for (int i = 0; i < 32; ++i) { const int kk = 2 * i + (lane >> 5); tv[i] = W[(size_t)(k0 + kk) * ldN + srccol + (lane & 31)]; }
#pragma unroll
    for (int i = 0; i < 32; ++i) { const int kk = 2 * i + (lane >> 5); scr[kk * 33 + (lane & 31)] = tv[i]; }
    LDSFENCE();
    const int c = lane & 7;
#pragma unroll
    for (int j = 0; j < 4; ++j) { const int n = (lane >> 3) + 8 * j; const float* s = scr + (8 * c) * 33 + n;
        u32x4 o; o.x = pk2(s[0 * 33], s[1 * 33]); o.y = pk2(s[2 * 33], s[3 * 33]); o.z = pk2(s[4 * 33], s[5 * 33]); o.w = pk2(s[6 * 33], s[7 * 33]);
        *(u32x4*)(WT + (size_t)(destrow + n) * K + k0 + 8 * c) = o; }
    LDSFENCE();
}

DI void phase0(const Params& P, unsigned char* lds, int tid, int G) {
    const int lane = tid & 63, wave = tid >> 6;
    unsigned char* ws = P.ws;
    float* scr = (float*)(lds + wave * 16384);
    const int gw = blockIdx.x * 8 + wave, NGW = G * 8;
    const float* Win = P.in[2];
    constexpr int I_IN = 16 * 192, I_UP = 8 * 32, I_OUT = 16 * 32;
    for (int it = gw; it < I_IN + 2 * I_UP + I_OUT; it += NGW) {
        int r = it;
        if (r < I_IN) { const int kb = r / 192, nb = r % 192, n0 = 32 * nb; const int src = n0 < 2048 ? n0 : (n0 < 4096 ? n0 + 16 : n0 + 24);
            p0_transpose_item(Win, DIN, src, (bf16_t*)(ws + WS_WIN), 1024, n0, 64 * kb, scr, lane); continue; }
        r -= I_IN;
        if (r < I_UP) { p0_transpose_item(P.in[12], 1024, 32 * (r % 32), (bf16_t*)(ws + WS_WUPA), 512, 32 * (r % 32), 64 * (r / 32), scr, lane); continue; }
        r -= I_UP;
        if (r < I_UP) { p0_transpose_item(P.in[13], 1024, 32 * (r % 32), (bf16_t*)(ws + WS_WUPB), 512, 32 * (r % 32), 64 * (r / 32), scr, lane); continue; }
        r -= I_UP;
        p0_transpose_item(P.in[14], 1024, 32 * (r % 32), (bf16_t*)(ws + WS_WOUT), 1024, 32 * (r % 32), 64 * (r / 32), scr, lane);
    }
    { bf16_t* wsm = (bf16_t*)(ws + WS_WSM);
      for (int idx = blockIdx.x * 512 + tid; idx < 32 * 1024; idx += G * 512) { const int n = idx >> 10, k = idx & 1023;
          float v = 0.f; if (n < 16) v = Win[(size_t)k * DIN + 2048 + n]; else if (n < 24) v = Win[(size_t)k * DIN + 4112 + (n - 16)];
          wsm[idx] = (bf16_t)(pk2(v, 0.f) & 0xffffu); } }
    { const float* x = P.in[0]; const float* nw = P.in[1]; bf16_t* H = (bf16_t*)(ws + WS_H);
      f32x4 wv[4];
#pragma unroll
      for (int j = 0; j < 4; ++j) wv[j] = *(const f32x4*)(nw + 4 * lane + 256 * j);
      for (int m0 = gw; m0 < SEQ; m0 += 4 * NGW) {
          f32x4 v[4][4];
#pragma unroll
          for (int q = 0; q < 4; ++q) { const int m = m0 + q * NGW < SEQ ? m0 + q * NGW : m0; const f32x4* xr = (const f32x4*)(x + (size_t)m * DM) + lane;
#pragma unroll
              for (int j = 0; j < 4; ++j) v[q][j] = __builtin_nontemporal_load(xr + 64 * j); }
#pragma unroll
          for (int q = 0; q < 4; ++q) { const int m = m0 + q * NGW; if (m < SEQ) { float s = 0.f;
#pragma unroll
              for (int j = 0; j < 4; ++j) s += (v[q][j].x * v[q][j].x + v[q][j].y * v[q][j].y) + (v[q][j].z * v[q][j].z + v[q][j].w * v[q][j].w);
              const float rstd = rsqrtf(wave_sum(s) * (1.f / DM) + EPS);
              u32x2* o8 = (u32x2*)(H + (size_t)m * DM) + lane;
#pragma unroll
              for (int j = 0; j < 4; ++j) { u32x2 o; o.x = pk2(v[q][j].x * rstd * wv[j].x, v[q][j].y * rstd * wv[j].y); o.y = pk2(v[q][j].z * rstd * wv[j].z, v[q][j].w * rstd * wv[j].w); o8[64 * j] = o; } } }
      } }
}

DI void small_proj(const Params& P, unsigned char* lds, int tid, int G) {
    const int lane = tid & 63, wave = tid >> 6;
    const bf16_t* H = (const bf16_t*)(P.ws + WS_H); const bf16_t* W = (const bf16_t*)(P.ws + WS_WSM); float* SM = (float*)(P.ws + WS_SMALL);
    const int r32 = lane & 31, hi = lane >> 5, ru = wave >> 2, kq = wave & 3;
    float* part = (float*)lds;
    for (int u2 = blockIdx.x; u2 < SEQ / 64; u2 += G) {
        const int u = 2 * u2 + ru;
        f32x16 acc; for (int i = 0; i < 16; ++i) acc[i] = 0.f;
        const bf16_t* ap = H + (size_t)(u * 32 + r32) * DM + 256 * kq + 8 * hi; const bf16_t* bp = W + (size_t)r32 * DM + 256 * kq + 8 * hi;
        bf16x8 a[16], b[16];
#pragma unroll
        for (int ks = 0; ks < 16; ++ks) { a[ks] = *(const bf16x8*)(ap + 16 * ks); b[ks] = *(const bf16x8*)(bp + 16 * ks); }
#pragma unroll
        for (int ks = 0; ks < 16; ++ks) acc = MFMA32(a[ks], b[ks], acc);
#pragma unroll
        for (int r = 0; r < 16; ++r) part[(wave * 16 + r) * 64 + lane] = acc[r];
        __syncthreads();
#pragma unroll
        for (int k = 0; k < 4; ++k) { const int o = tid + 512 * k, uu = o >> 10, r = (o >> 6) & 15, l = o & 63;
            const float v = part[((uu * 4 + 0) * 16 + r) * 64 + l] + part[((uu * 4 + 1) * 16 + r) * 64 + l] + part[((uu * 4 + 2) * 16 + r) * 64 + l] + part[((uu * 4 + 3) * 16 + r) * 64 + l];
            const int row = (r & 3) + 8 * (r >> 2) + 4 * (l >> 5);
            SM[(size_t)((2 * u2 + uu) * 32 + row) * 32 + (l & 31)] = v; }
        __syncthreads();
    }
}

DI int permpos(int a) { return 32 * (a >> 5) + 8 * ((a >> 2) & 3) + 4 * ((a >> 4) & 1) + (a & 3); }
#define PREP_BAR() do { asm volatile("s_waitcnt lgkmcnt(0)\n\ts_barrier" ::: "memory"); } while (0)
DI void gdn_load(const Params& P, int u, int tid, u32x4 (&raw)[12], float& sb, float& sa) {
    const int h = u & 7, n = u >> 3, t = tid >> 3, c8 = tid & 7, tok = n * 64 + t;
    const bf16_t* PROJ = (const bf16_t*)(P.ws + WS_PROJ); const float* SM = (const float*)(P.ws + WS_SMALL);
#pragma unroll
    for (int xx = 0; xx < 3; ++xx)
#pragma unroll
        for (int j = 0; j < 4; ++j) { const int tk = tok - 3 + j; u32x4 v = {0u, 0u, 0u, 0u};
            if (tk >= 0) v = *(const u32x4*)(PROJ + (size_t)xx * BUF_ELEMS + h * 64 + 8 * c8 + (size_t)tk * 512);
            raw[xx * 4 + j] = v; }
    sb = SM[(size_t)tok * 32 + h]; sa = SM[(size_t)tok * 32 + 8 + h];
}
DI void gdn_prep_unit(const Params& P, int h, int n, unsigned char* lds, int tid, u32x4 (&raw)[12], float& sbv, float& sav, int unext, bool cw_lds = false) {
    unsigned char* ws = P.ws;
    bf16_t* Kimg = (bf16_t*)(lds); bf16_t* Qimg = (bf16_t*)(lds + 9216);
    float* Ml = (float*)(lds + 18432); float* X = (float*)(lds + 35840);
    float* graw = (float*)(lds + 69632); float* gcs = graw + 64; float* bet = graw + 128;
    bf16_t* Aimg = (bf16_t*)(lds + 76800);
    const bf16_t* PROJ = (const bf16_t*)(ws + WS_PROJ); const float* SM = (const float*)(ws + WS_SMALL);
    const float* convw = P.in[4];
    const int unit = h * 256 + n;
    bf16_t* IMG = (bf16_t*)P.out + (size_t)unit * 16384;
    const int lane = tid & 63, wave = tid >> 6;
    const int t = tid >> 3, c8 = tid & 7, tok = n * 64 + t;
    float y[3][8];
#pragma unroll
    for (int xx = 0; xx < 3; ++xx) {
        float acc[8];
#pragma unroll
        for (int e = 0; e < 8; ++e) acc[e] = 0.f;
#pragma unroll
        for (int j = 0; j < 4; ++j) { const u32x4 rw = raw[xx * 4 + j];
            const float* wp = cw_lds ? (const float*)(lds + 86016) + (j * 3 + xx) * 64 + 8 * c8 : convw + j * 1536 + xx * 512 + h * 64 + 8 * c8;
            const f32x4 w0 = *(const f32x4*)wp, w1 = *(const f32x4*)(wp + 4);
            acc[0] += w0.x * bflo(rw.x); acc[1] += w0.y * bfhi(rw.x); acc[2] += w0.z * bflo(rw.y); acc[3] += w0.w * bfhi(rw.y);
            acc[4] += w1.x * bflo(rw.z); acc[5] += w1.y * bfhi(rw.z); acc[6] += w1.z * bflo(rw.w); acc[7] += w1.w * bfhi(rw.w); }
#pragma unroll
        for (int e = 0; e < 8; ++e) y[xx][e] = acc[e] * sigmf(acc[e]);
    }
    const float sb_c = sbv, sa_c = sav;
    float ssq = 0.f, ssk = 0.f;
#pragma unroll
    for (int e = 0; e < 8; ++e) { ssq += y[0][e] * y[0][e]; ssk += y[1][e] * y[1][e]; }
    ssq += dpp_xor1(ssq); ssq += dpp_xor2(ssq); ssq += dpp_half_mirror(ssq);
    ssk += dpp_xor1(ssk); ssk += dpp_xor2(ssk); ssk += dpp_half_mirror(ssk);
    const float rq = rsqrtf(ssq + EPS) * 0.125f, rk = rsqrtf(ssk + EPS);
    const float beta = sigmf(sb_c);
    const float gt = -__expf(P.in[5][h]) * softplusf(sa_c + P.in[6][h]);
    graw[t] = gt; bet[t] = beta;
    PREP_BAR();
    if (wave == 0) gcs[lane] = wave_incl_scan(graw[lane]);
    PREP_BAR();
    const float gc = gcs[t];
    const float eg = __expf(gc);
    { u32x4 kk, qq; float q[8], k[8];
#pragma unroll
      for (int e = 0; e < 8; ++e) { q[e] = y[0][e] * rq; k[e] = y[1][e] * rk; }
      kk.x = pk2(k[0], k[1]); kk.y = pk2(k[2], k[3]); kk.z = pk2(k[4], k[5]); kk.w = pk2(k[6], k[7]);
      qq.x = pk2(q[0], q[1]); qq.y = pk2(q[2], q[3]); qq.z = pk2(q[4], q[5]); qq.w = pk2(q[6], q[7]);
      *(u32x4*)(Kimg + t * 72 + 8 * c8) = kk; *(u32x4*)(Qimg + t * 72 + 8 * c8) = qq;
#pragma unroll
      for (int e = 0; e < 8; e += 4) { const float kb = beta * eg;
          *(f32x4*)(X + t * 132 + 8 * c8 + e) = (f32x4){y[2][e] * beta, y[2][e + 1] * beta, y[2][e + 2] * beta, y[2][e + 3] * beta};
          *(f32x4*)(X + t * 132 + 64 + 8 * c8 + e) = (f32x4){k[e] * kb, k[e + 1] * kb, k[e + 2] * kb, k[e + 3] * kb}; }
      const int p0 = 32 * (c8 >> 2) + 16 * (c8 & 1) + 4 * ((c8 >> 1) & 1);
      u32x2 a, b; a.x = pk2(q[0] * eg, q[1] * eg); a.y = pk2(q[2] * eg, q[3] * eg); b.x = pk2(q[4] * eg, q[5] * eg); b.y = pk2(q[6] * eg, q[7] * eg);
      const int swt = (t >> 1) & 7, ch0 = p0 >> 3, wi = p0 & 7;
      *(u32x2*)(IMG + 4096 + t * 64 + ((ch0 ^ swt) << 3) + wi) = a; *(u32x2*)(IMG + 4096 + t * 64 + (((ch0 + 1) ^ swt) << 3) + wi) = b; }
    PREP_BAR();
    { const int l15 = lane & 15, g = lane >> 4;
#pragma unroll
      for (int bb = 0; bb < 2; ++bb) { const int blk = 2 * wave + bb, bi = blk >> 2, bj = blk & 3;
          f32x4 aq = {0.f, 0.f, 0.f, 0.f}, ak = {0.f, 0.f, 0.f, 0.f};
#pragma unroll
          for (int s = 0; s < 2; ++s) {
              const bf16x8 bk = *(const bf16x8*)(Kimg + (16 * bj + l15) * 72 + 32 * s + 8 * g);
              const bf16x8 aqf = *(const bf16x8*)(Qimg + (16 * bi + l15) * 72 + 32 * s + 8 * g);
              aq = MFMA16(aqf, bk, aq);
              if (bj <= bi) { const bf16x8 akf = *(const bf16x8*)(Kimg + (16 * bi + l15) * 72 + 32 * s + 8 * g); ak = MFMA16(akf, bk, ak); }
          }
          const int j = 16 * bj + l15; const float gj = gcs[j]; const int pj = permpos(j);
#pragma unroll
          for (int r = 0; r < 4; ++r) { const int i = 16 * bi + 4 * g + r; const float dec = (j <= i) ? __expf(gcs[i] - gj) : 0.f;
              Aimg[i * 64 + ((((pj >> 3) ^ (i >> 1)) & 7) << 3) + (pj & 7)] = (bf16_t)(pk2(aq[r] * dec, 0.f) & 0xffffu);
              if (bj <= bi) Ml[i * 68 + j] = (j < i) ? bet[i] * ak[r] * dec : 0.f; }
      } }
    PREP_BAR();
    if (unext >= 0) gdn_load(P, unext, tid, raw, sbv, sav);
    float* Tl = (float*)(lds + 70400);
    if (wave < 4) { const int b = wave, col = lane >> 2, q4 = lane & 3;
      float xr[4] = {0.f, 0.f, 0.f, 0.f};
#pragma unroll
      for (int p = 0; p < 8; ++p) { const int i0 = 2 * p, i1 = 2 * p + 1;
          const float* d0 = Ml + (16 * b + i0) * 68 + 16 * b; const float* d1 = Ml + (16 * b + i1) * 68 + 16 * b;
          float p0 = 0.f, p1 = 0.f;
#pragma unroll
          for (int m = 0; m < (i1 + 3) / 4; ++m) { p0 += d0[4 * m + q4] * xr[m]; p1 += d1[4 * m + q4] * xr[m]; }
          p0 += dpp_xor1(p0); p1 += dpp_xor1(p1); p0 += dpp_xor2(p0); p1 += dpp_xor2(p1);
          const float x0 = (i0 == col ? 1.f : 0.f) - p0;
          const float x1 = (i1 == col ? 1.f : 0.f) - p1 - d1[i0] * x0;
          if (q4 == (i0 & 3)) xr[i0 >> 2] = x0;
          if (q4 == (i1 & 3)) xr[i1 >> 2] = x1;
          Tl[(16 * b + i0) * 20 + col] = x0; Tl[(16 * b + i1) * 20 + col] = x1;
      } }
    else {
      const float glast = gcs[63];
#pragma unroll
      for (int k2 = 0; k2 < 2; ++k2) { const int it_ = (tid - 256) + 256 * k2, c = it_ >> 3, pg = it_ & 7, s = pg >> 2, g = pg & 3;
          float w[8];
#pragma unroll
          for (int j = 0; j < 8; ++j) { const int d = 32 * s + 16 * (j >> 2) + 4 * g + (j & 3); w[j] = bf2f(Kimg[d * 72 + c]) * __expf(glast - gcs[d]); }
          u32x4 o2; o2.x = pk2(w[0], w[1]); o2.y = pk2(w[2], w[3]); o2.z = pk2(w[4], w[5]); o2.w = pk2(w[6], w[7]);
          *(u32x4*)(IMG + 12288 + c * 64 + 8 * ((pg ^ (c >> 1)) & 7)) = o2;
          *(u32x4*)(IMG + 8192 + it_ * 8) = *(const u32x4*)(Aimg + it_ * 8); }
      if (tid == 256) ((float*)(ws + WS_GL))[unit] = __expf(glast); }
    PREP_BAR();
    { const int l15 = lane & 15, g = lane >> 4;
      u32x2 xh[4];
#pragma unroll
      for (int b = 0; b < 4; ++b) {
          float* xp = X + (16 * b + 4 * g) * 132 + 16 * wave + l15;
          f32x4 acc = {xp[0], xp[132], xp[264], xp[396]};
#pragma unroll
          for (int bp = 0; bp < b; bp += 2) {
              const f32x4 a0 = *(const f32x4*)(Ml + (16 * b + l15) * 68 + 16 * bp + 4 * g);
              f32x4 a1 = {0.f, 0.f, 0.f, 0.f}; u32x2 x1 = {0u, 0u};
              if (bp + 1 < b) { a1 = *(const f32x4*)(Ml + (16 * b + l15) * 68 + 16 * (bp + 1) + 4 * g); x1 = xh[bp + 1]; }
              u32x4 ap; ap.x = pk2(-a0[0], -a0[1]); ap.y = pk2(-a0[2], -a0[3]); ap.z = pk2(-a1[0], -a1[1]); ap.w = pk2(-a1[2], -a1[3]);
              u32x4 bpk; bpk.x = xh[bp].x; bpk.y = xh[bp].y; bpk.z = x1.x; bpk.w = x1.y;
              acc = MFMA16(__builtin_bit_cast(bf16x8, ap), __builtin_bit_cast(bf16x8, bpk), acc); }
          const f32x4 tt = *(const f32x4*)(Tl + (16 * b + l15) * 20 + 4 * g);
          f32x4 xb = {0.f, 0.f, 0.f, 0.f};
          { u32x4 tp; tp.x = pk2(tt[0], tt[1]); tp.y = pk2(tt[2], tt[3]); tp.z = 0u; tp.w = 0u;
            u32x4 rp; rp.x = pk2(acc[0], acc[1]); rp.y = pk2(acc[2], acc[3]); rp.z = 0u; rp.w = 0u;
            xb = MFMA16(__builtin_bit_cast(bf16x8, tp), __builtin_bit_cast(bf16x8, rp), xb); }
          xh[b].x = pk2(xb[0], xb[1]); xh[b].y = pk2(xb[2], xb[3]);
          xp[0] = xb[0]; xp[132] = xb[1]; xp[264] = xb[2]; xp[396] = xb[3];
      } }
    PREP_BAR();
    { bf16_t* WB = (bf16_t*)(ws + WS_WB) + (size_t)unit * 4096;
#pragma unroll
      for (int k = 0; k < 2; ++k) { const int gidx = tid + 512 * k, cgi = gidx >> 8, mb = (gidx >> 6) & 3, l = gidx & 63;
          const float* xp = X + (16 * mb + 4 * (l >> 4)) * 132 + 16 * cgi + (l & 15);
          u32x2 o; o.x = pk2(xp[0], xp[132]); o.y = pk2(xp[264], xp[396]); *(u32x2*)(WB + gidx * 4) = o; }
      const int c = tid >> 3, pg = tid & 7, s = pg >> 2, g = pg & 3;
      float v[8];
#pragma unroll
      for (int j = 0; j < 8; ++j) { const int d = 32 * s + 16 * (j >> 2) + 4 * g + (j & 3); v[j] = -X[c * 132 + 64 + d]; }
      u32x4 o1; o1.x = pk2(v[0], v[1]); o1.y = pk2(v[2], v[3]); o1.z = pk2(v[4], v[5]); o1.w = pk2(v[6], v[7]);
      *(u32x4*)(IMG + c * 64 + 8 * ((pg ^ (c >> 1)) & 7)) = o1; }
}

DI void fox_prep_unit(const Params& P, int n, unsigned char* lds, int tid) {
    unsigned char* ws = P.ws;
    const int h = tid >> 6, t = tid & 63, tok = n * 64 + t;
    bf16_t* FQ = (bf16_t*)(ws + WS_PROJ) + 4 * BUF_ELEMS + (size_t)tok * 512 + h * 64;
    bf16_t* FK = (bf16_t*)(ws + WS_PROJ) + 5 * BUF_ELEMS + (size_t)tok * 512 + h * 64;
    const bf16_t* FV = (const bf16_t*)(ws + WS_PROJ) + 6 * BUF_ELEMS + (size_t)tok * 512 + h * 64;
#pragma unroll
    for (int which = 0; which < 2; ++which) {
        bf16_t* ptr = which ? FK : FQ; const float* nw = which ? P.in[10] : P.in[9]; const float sc = which ? 1.0f : 0.125f * 1.4426950408889634f;
        u32x4 raw[8]; float ss = 0.f;
#pragma unroll
        for (int i = 0; i < 8; ++i) { raw[i] = *(const u32x4*)(ptr + 8 * i);
            const float a0 = bflo(raw[i].x), a1 = bfhi(raw[i].x), a2 = bflo(raw[i].y), a3 = bfhi(raw[i].y), a4 = bflo(raw[i].z), a5 = bfhi(raw[i].z), a6 = bflo(raw[i].w), a7 = bfhi(raw[i].w);
            ss += (a0 * a0 + a1 * a1) + (a2 * a2 + a3 * a3) + (a4 * a4 + a5 * a5) + (a6 * a6 + a7 * a7); }
        const float rstd = rsqrtf(ss * (1.f / 64.f) + EPS) * sc;
#pragma unroll
        for (int i = 0; i < 8; ++i) { const f32x4 w0 = *(const f32x4*)(nw + 8 * i), w1 = *(const f32x4*)(nw + 8 * i + 4); u32x4 o;
            o.x = pk2(bflo(raw[i].x) * rstd * w0.x, bfhi(raw[i].x) * rstd * w0.y); o.y = pk2(bflo(raw[i].y) * rstd * w0.z, bfhi(raw[i].y) * rstd * w0.w);
            o.z = pk2(bflo(raw[i].z) * rstd * w1.x, bfhi(raw[i].z) * rstd * w1.y); o.w = pk2(bflo(raw[i].w) * rstd * w1.z, bfhi(raw[i].w) * rstd * w1.w);
            *(u32x4*)(ptr + 8 * i) = o; }
    }
    { bf16_t* tile = (bf16_t*)(lds + h * 9216);
#pragma unroll
      for (int i = 0; i < 8; ++i) { const u32x4 r = *(const u32x4*)(FV + 8 * i);
          tile[(8 * i + 0) * 72 + t] = (bf16_t)(r.x & 0xffffu); tile[(8 * i + 1) * 72 + t] = (bf16_t)(r.x >> 16);
          tile[(8 * i + 2) * 72 + t] = (bf16_t)(r.y & 0xffffu); tile[(8 * i + 3) * 72 + t] = (bf16_t)(r.y >> 16);
          tile[(8 * i + 4) * 72 + t] = (bf16_t)(r.z & 0xffffu); tile[(8 * i + 5) * 72 + t] = (bf16_t)(r.z >> 16);
          tile[(8 * i + 6) * 72 + t] = (bf16_t)(r.w & 0xffffu); tile[(8 * i + 7) * 72 + t] = (bf16_t)(r.w >> 16); }
      LDSFENCE();
      bf16_t* VT = (bf16_t*)(ws + WS_VT) + (size_t)(h * 64) * SEQ + (size_t)n * 64;
#pragma unroll
      for (int k = 0; k < 8; ++k) { const int idx = t + 64 * k, d = idx >> 3, c = idx & 7;
          *(u32x4*)(VT + (size_t)d * SEQ + 8 * c) = *(const u32x4*)(tile + d * 72 + 8 * c); }
      LDSFENCE(); }
    { const float f = ((const float*)(ws + WS_SMALL))[(size_t)tok * 32 + 16 + h] + P.in[8][h];
      float v = -softplusf(-f) * 1.4426950408889634f;
      v = wave_incl_scan(v);
      ((float*)(ws + WS_CL))[(size_t)h * SEQ + tok] = v;
      if (t == 63) ((float*)(ws + WS_CT))[h * 256 + n] = v; }
}

constexpr int SCAN_L = 8, SCAN_G = 256 / SCAN_L;
#define SCAN_BAR() do { __builtin_amdgcn_sched_barrier(0); asm volatile("s_waitcnt lgkmcnt(0)\n\ts_barrier" ::: "memory"); __builtin_amdgcn_sched_barrier(0); } while (0)
#define ORDER_FENCE() do { asm volatile("" ::: "memory"); __builtin_amdgcn_sched_barrier(0); } while (0)
DI bf16x8 pack8(const f32x4& a, const f32x4& b) { u32x4 p; p.x = pk2(a[0], a[1]); p.y = pk2(a[2], a[3]); p.z = pk2(b[0], b[1]); p.w = pk2(b[2], b[3]); return __builtin_bit_cast(bf16x8, p); }
template <bool PASS1>
DI void gdn_scan(const Params& P, int h, int g, unsigned char* lds, LAS unsigned char* ldsl, int tid) {
    unsigned char* ws = P.ws;
    const int lane = tid & 63, wave = __builtin_amdgcn_readfirstlane(tid >> 6);
    const int c0 = g * SCAN_L;
    bf16_t* obuf = (bf16_t*)(lds + 131072);
    float* gll = (float*)(lds + 149504);
    const bf16_t* IMGH = (const bf16_t*)P.out + (size_t)(h * 256 + c0) * 16384;
    const float* GLp = (const float*)(ws + WS_GL) + h * 256 + c0;
    bf16_t* PIMG = (bf16_t*)(ws + WS_PG);
    float* QACC = (float*)(ws + WS_QG);
    if (wave >= 6) {
        if constexpr (PASS1) {
            for (int n = 0; n <= SCAN_L; ++n) SCAN_BAR();
        } else {
        const int ftid = tid - 384, tl = ftid >> 1, e0 = 32 * (ftid & 1);
        float gw[32];
#pragma unroll
        for (int e = 0; e < 32; ++e) gw[e] = P.in[7][e0 + e];
        const bf16_t* GZ = (const bf16_t*)(ws + WS_PROJ) + 3 * BUF_ELEMS + h * 64 + e0 + (size_t)(c0 * 64 + tl) * 512;
        bf16_t* YA = (bf16_t*)(ws + WS_PROJ) + 0 * BUF_ELEMS + h * 64 + e0 + (size_t)(c0 * 64 + tl) * 512;
        u32x4 Z0[4], Z1[4], Z2[4], Z3[4];
#define LDZ(Z, u_) do { const int uu_ = (u_) < SCAN_L ? (u_) : SCAN_L - 1; _Pragma("unroll") for (int i = 0; i < 4; ++i) Z[i] = *(const u32x4*)(GZ + (size_t)uu_ * 32768 + 8 * i); } while (0)
#define FSIG(z) __builtin_amdgcn_rcpf(1.0f + __expf(-(z)))
#define FIN_STEP(Z, nn_) do { const int nn = (nn_); \
            const bf16_t* ob = obuf + (nn & 1) * 4608 + tl * 72 + e0; \
            float of[32]; float ss = 0.f; \
            _Pragma("unroll") for (int i = 0; i < 4; ++i) { const u32x4 ov = *(const u32x4*)(ob + 8 * i); \
                of[8 * i] = bflo(ov.x); of[8 * i + 1] = bfhi(ov.x); of[8 * i + 2] = bflo(ov.y); of[8 * i + 3] = bfhi(ov.y); \
                of[8 * i + 4] = bflo(ov.z); of[8 * i + 5] = bfhi(ov.z); of[8 * i + 6] = bflo(ov.w); of[8 * i + 7] = bfhi(ov.w); } \
            _Pragma("unroll") for (int e = 0; e < 32; ++e) ss += of[e] * of[e]; \
            ss += dpp_xor1(ss); \
            const float rstd = rsqrtf(ss * (1.f / 64.f) + EPS); \
            _Pragma("unroll") for (int i = 0; i < 4; ++i) { \
                const float z0 = bflo(Z[i].x), z1 = bfhi(Z[i].x), z2 = bflo(Z[i].y), z3 = bfhi(Z[i].y), z4 = bflo(Z[i].z), z5 = bfhi(Z[i].z), z6 = bflo(Z[i].w), z7 = bfhi(Z[i].w); \
                u32x4 w; \
                w.x = pk2(of[8 * i] * rstd * gw[8 * i] * z0 * FSIG(z0), of[8 * i + 1] * rstd * gw[8 * i + 1] * z1 * FSIG(z1)); \
                w.y = pk2(of[8 * i + 2] * rstd * gw[8 * i + 2] * z2 * FSIG(z2), of[8 * i + 3] * rstd * gw[8 * i + 3] * z3 * FSIG(z3)); \
                w.z = pk2(of[8 * i + 4] * rstd * gw[8 * i + 4] * z4 * FSIG(z4), of[8 * i + 5] * rstd * gw[8 * i + 5] * z5 * FSIG(z5)); \
                w.w = pk2(of[8 * i + 6] * rstd * gw[8 * i + 6] * z6 * FSIG(z6), of[8 * i + 7] * rstd * gw[8 * i + 7] * z7 * FSIG(z7)); \
                *(u32x4*)(YA + (size_t)nn * 32768 + 8 * i) = w; } \
            LDZ(Z, nn + 4); } while (0)
        LDZ(Z0, 0); ORDER_FENCE(); LDZ(Z1, 1); ORDER_FENCE(); LDZ(Z2, 2); ORDER_FENCE(); LDZ(Z3, 3); ORDER_FENCE();
        if (g > 0) for (int i = 0; i <= g; ++i) SCAN_BAR();
        SCAN_BAR();
        SCAN_BAR();
        for (int nb = 0; nb < SCAN_L; nb += 4) {
            FIN_STEP(Z0, nb); SCAN_BAR(); FIN_STEP(Z1, nb + 1); SCAN_BAR(); FIN_STEP(Z2, nb + 2); SCAN_BAR(); FIN_STEP(Z3, nb + 3); if (nb + 3 < SCAN_L - 1) SCAN_BAR();
        }
#undef FIN_STEP
#undef FSIG
#undef LDZ
        }
    } else if (wave >= 4) {
        const int dw = wave - 4;
        constexpr int NP = PASS1 ? 8 : 16;
        const int piece0 = PASS1 ? 24 * dw : 16 * dw;
#define DMA_UNIT(u, slot) do { const char* src_ = (const char*)(IMGH + (size_t)(u) * 16384) + piece0 * 1024 + lane * 16; \
        _Pragma("unroll") for (int k_ = 0; k_ < NP; ++k_) __builtin_amdgcn_global_load_lds((const unsigned*)(src_ + k_ * 1024), (LAS unsigned*)(ldsl + (slot) * 32768 + (piece0 + k_) * 1024), 16, 0, 0); } while (0)
        if constexpr (!PASS1) { if (g > 0) {
            const char* pq_p = (const char*)(PIMG + (size_t)(h * SCAN_G) * 4096) + dw * 4096 + lane * 16;
            const char* pq_q = (const char*)(QACC + (size_t)(h * SCAN_G) * 4096) + dw * 8192 + lane * 16;
#define DMA_PQ(gi_, slot) do { const int gi = (gi_) < g ? (gi_) : g - 1; \
            _Pragma("unroll") for (int k_ = 0; k_ < 4; ++k_) __builtin_amdgcn_global_load_lds((const unsigned*)(pq_p + (size_t)gi * 8192 + k_ * 1024), (LAS unsigned*)(ldsl + (slot) * 24576 + dw * 4096 + k_ * 1024), 16, 0, 0); \
            _Pragma("unroll") for (int k_ = 0; k_ < 8; ++k_) __builtin_amdgcn_global_load_lds((const unsigned*)(pq_q + (size_t)gi * 16384 + k_ * 1024), (LAS unsigned*)(ldsl + (slot) * 24576 + 8192 + dw * 8192 + k_ * 1024), 16, 0, 0); } while (0)
            DMA_PQ(0, 0); DMA_PQ(1, 1); DMA_PQ(2, 2); DMA_PQ(3, 3);
            asm volatile("s_waitcnt vmcnt(36)" ::: "memory");
            SCAN_BAR();
            for (int gp = 0; gp < g; ++gp) {
                DMA_PQ(gp + 4, (gp + 4) % 5);
                asm volatile("s_waitcnt vmcnt(36)" ::: "memory");
                SCAN_BAR();
            }
            asm volatile("s_waitcnt vmcnt(0)" ::: "memory");
#undef DMA_PQ
        } }
        DMA_UNIT(0, 0); DMA_UNIT(1, 1); DMA_UNIT(2, 2);
        if constexpr (PASS1) asm volatile("s_waitcnt vmcnt(16)" ::: "memory"); else asm volatile("s_waitcnt vmcnt(32)" ::: "memory");
        SCAN_BAR();
        for (int n = 0; n < SCAN_L; ++n) {
            const int un = n + 3 < SCAN_L ? n + 3 : SCAN_L - 1;
            DMA_UNIT(un, (n + 3) & 3);
            if constexpr (PASS1) asm volatile("s_waitcnt vmcnt(16)" ::: "memory"); else asm volatile("s_waitcnt vmcnt(32)" ::: "memory");
            SCAN_BAR();
        }
        asm volatile("s_waitcnt vmcnt(0)" ::: "memory");
#undef DMA_UNIT
    } else {
        const int cgi = wave, l15 = lane & 15, gq = lane >> 4;
        const bf16_t* WBH = (const bf16_t*)(ws + WS_WB) + (size_t)(h * 256 + c0) * 4096 + cgi * 1024 + lane * 4;
        if (tid < SCAN_L) gll[tid] = GLp[tid];
        f32x4 S[4];
#pragma unroll
        for (int mb = 0; mb < 4; ++mb) S[mb] = (f32x4){0.f, 0.f, 0.f, 0.f};
        u32x2 W0[4], W1[4], W2[4], W3[4];
#define LDW(W, u_) do { const int uu_ = (u_) < SCAN_L ? (u_) : SCAN_L - 1; _Pragma("unroll") for (int mb = 0; mb < 4; ++mb) W[mb] = *(const u32x2*)(WBH + (size_t)uu_ * 4096 + mb * 256); } while (0)
        const int aoff0 = l15 * 128 + ((gq ^ (l15 >> 1)) << 4), aoff1 = l15 * 128 + (((4 + gq) ^ (l15 >> 1)) << 4);
#define AFR(mat, mb, s) (*(const bf16x8*)(sb + (mat) * 8192 + (mb) * 2048 + ((s) ? aoff1 : aoff0)))
        if constexpr (PASS1) {
            f32x4 T[4];
#pragma unroll
            for (int mb = 0; mb < 4; ++mb)
#pragma unroll
                for (int r = 0; r < 4; ++r) T[mb][r] = (16 * mb + 4 * gq + r == 16 * cgi + l15) ? 1.f : 0.f;
            LDW(W0, 0); ORDER_FENCE(); LDW(W1, 1); ORDER_FENCE(); LDW(W2, 2); ORDER_FENCE(); LDW(W3, 3); ORDER_FENCE();
            SCAN_BAR();
#define P1_STEP(W, n_) do { const int nq_ = (n_); \
            const unsigned char* sb = lds + (nq_ & 3) * 32768; const float glc = gll[nq_]; \
            bf16x8 Sb[2], Tb[2], Ub[2], Vb[2]; \
            _Pragma("unroll") for (int s = 0; s < 2; ++s) { Sb[s] = pack8(S[2 * s], S[2 * s + 1]); Tb[s] = pack8(T[2 * s], T[2 * s + 1]); } \
            f32x4 u[4], v[4]; \
            _Pragma("unroll") for (int mb = 0; mb < 4; ++mb) { const bf16x8 a0 = AFR(0, mb, 0), a1 = AFR(0, mb, 1); \
                u[mb] = (f32x4){bflo(W[mb].x), bfhi(W[mb].x), bflo(W[mb].y), bfhi(W[mb].y)}; v[mb] = (f32x4){0.f, 0.f, 0.f, 0.f}; \
                u[mb] = MFMA16(a0, Sb[0], u[mb]); v[mb] = MFMA16(a0, Tb[0], v[mb]); u[mb] = MFMA16(a1, Sb[1], u[mb]); v[mb] = MFMA16(a1, Tb[1], v[mb]); } \
            LDW(W, nq_ + 4); \
            _Pragma("unroll") for (int s = 0; s < 2; ++s) { Ub[s] = pack8(u[2 * s], u[2 * s + 1]); Vb[s] = pack8(v[2 * s], v[2 * s + 1]); } \
            _Pragma("unroll") for (int mb = 0; mb < 4; ++mb) { const bf16x8 a0 = AFR(3, mb, 0), a1 = AFR(3, mb, 1); S[mb] = S[mb] * glc; T[mb] = T[mb] * glc; \
                S[mb] = MFMA16(a0, Ub[0], S[mb]); T[mb] = MFMA16(a0, Vb[0], T[mb]); S[mb] = MFMA16(a1, Ub[1], S[mb]); T[mb] = MFMA16(a1, Vb[1], T[mb]); } \
            SCAN_BAR(); } while (0)
            for (int n = 0; n < SCAN_L; n += 4) { P1_STEP(W0, n); P1_STEP(W1, n + 1); P1_STEP(W2, n + 2); P1_STEP(W3, n + 3); }
#undef P1_STEP
            bf16_t* pim = PIMG + (size_t)(h * SCAN_G + g) * 4096; const int pj = permpos(16 * cgi + l15);
            float* qac = QACC + (size_t)(h * SCAN_G + g) * 4096 + cgi * 1024 + lane * 4;
#pragma unroll
            for (int mb = 0; mb < 4; ++mb) {
#pragma unroll
                for (int r = 0; r < 4; ++r) { const int d_ = 16 * mb + 4 * gq + r; pim[d_ * 64 + ((((pj >> 3) ^ (d_ >> 1)) & 7) << 3) + (pj & 7)] = (bf16_t)(pk2(T[mb][r], 0.f) & 0xffffu); }
                *(f32x4*)(qac + mb * 256) = S[mb]; }
        } else {
            LDW(W0, 0); ORDER_FENCE(); LDW(W1, 1); ORDER_FENCE(); LDW(W2, 2); ORDER_FENCE(); LDW(W3, 3); ORDER_FENCE();
            if (g > 0) {
                SCAN_BAR();
                for (int gp = 0; gp < g; ++gp) {
                    const unsigned char* sb = lds + (gp % 5) * 24576;
                    const bf16x8 s0 = pack8(S[0], S[1]), s1 = pack8(S[2], S[3]);
#pragma unroll
                    for (int mb = 0; mb < 4; ++mb) { const f32x4 q = *(const f32x4*)(sb + 8192 + (cgi * 1024 + mb * 256 + lane * 4) * 4);
                        f32x4 a = MFMA16(*(const bf16x8*)(sb + mb * 2048 + aoff0), s0, q); S[mb] = MFMA16(*(const bf16x8*)(sb + mb * 2048 + aoff1), s1, a); }
                    SCAN_BAR();
                }
            }
            SCAN_BAR();
#define SCAN_STEP(W, n_) do { const int nq_ = (n_); \
            const unsigned char* sb = lds + (nq_ & 3) * 32768; const float glc = gll[nq_]; \
            bf16x8 Sb[2], Ub[2]; \
            _Pragma("unroll") for (int s = 0; s < 2; ++s) Sb[s] = pack8(S[2 * s], S[2 * s + 1]); \
            f32x4 u[4], o[4]; \
            _Pragma("unroll") for (int mb = 0; mb < 4; ++mb) { u[mb] = (f32x4){bflo(W[mb].x), bfhi(W[mb].x), bflo(W[mb].y), bfhi(W[mb].y)}; \
                u[mb] = MFMA16(AFR(0, mb, 0), Sb[0], u[mb]); u[mb] = MFMA16(AFR(0, mb, 1), Sb[1], u[mb]); } \
            LDW(W, nq_ + 4); \
            _Pragma("unroll") for (int mb = 0; mb < 4; ++mb) { o[mb] = (f32x4){0.f, 0.f, 0.f, 0.f}; \
                o[mb] = MFMA16(AFR(1, mb, 0), Sb[0], o[mb]); o[mb] = MFMA16(AFR(1, mb, 1), Sb[1], o[mb]); } \
            _Pragma("unroll") for (int s = 0; s < 2; ++s) Ub[s] = pack8(u[2 * s], u[2 * s + 1]); \
            _Pragma("unroll") for (int mb = 0; mb < 4; ++mb) { S[mb] = S[mb] * glc; \
                S[mb] = MFMA16(AFR(3, mb, 0), Ub[0], S[mb]); S[mb] = MFMA16(AFR(3, mb, 1), Ub[1], S[mb]); } \
            _Pragma("unroll") for (int mb = 0; mb < 4; ++mb) { o[mb] = MFMA16(AFR(2, mb, 0), Ub[0], o[mb]); o[mb] = MFMA16(AFR(2, mb, 1), Ub[1], o[mb]); } \
            bf16_t* ob = obuf + (nq_ & 1) * 4608 + 16 * cgi + l15; \
            _Pragma("unroll") for (int mb = 0; mb < 4; ++mb) _Pragma("unroll") for (int r = 0; r < 4; ++r) ob[(16 * mb + 4 * gq + r) * 72] = (bf16_t)(pk2(o[mb][r], 0.f) & 0xffffu); \
            SCAN_BAR(); } while (0)
            for (int n = 0; n < SCAN_L; n += 4) { SCAN_STEP(W0, n); SCAN_STEP(W1, n + 1); SCAN_STEP(W2, n + 2); SCAN_STEP(W3, n + 3); }
#undef SCAN_STEP
        }
#undef AFR
#undef LDW
    }
}

DI void fox_attn_unit(const Params& P, int tid, int h, int qb, float PRUNE, int pir) {
    unsigned char* ws = P.ws;
    const int lane = tid & 63, wave = tid >> 6, r32 = lane & 31, hi = lane >> 5;
    const bf16_t* QN = (const bf16_t*)(ws + WS_PROJ) + 4 * BUF_ELEMS; const bf16_t* KN = (const bf16_t*)(ws + WS_PROJ) + 5 * BUF_ELEMS;
    const bf16_t* FZ = (const bf16_t*)(ws + WS_PROJ) + 7 * BUF_ELEMS; bf16_t* YB = (bf16_t*)(ws + WS_PROJ) + 1 * BUF_ELEMS;
    const bf16_t* VT = (const bf16_t*)(ws + WS_VT); const float* CL = (const float*)(ws + WS_CL); const float* CT = (const float*)(ws + WS_CT);
    (void)wave;
    const int t0 = qb * 32, nq = qb >> 1;
    const float* CLh = CL + (size_t)h * SEQ; const float* CTh = CT + h * 256;
    const bf16_t* KNh = KN + h * 64 + 8 * hi; const bf16_t* VTh = VT + (size_t)(h * 64 + r32) * SEQ + 8 * hi;
    bf16x8 qf[4];
#pragma unroll
    for (int ks = 0; ks < 4; ++ks) qf[ks] = *(const bf16x8*)(QN + (size_t)(t0 + r32) * 512 + h * 64 + 16 * ks + 8 * hi);
    const float cq = CLh[t0 + r32];
    const float cq0 = __uint_as_float(__builtin_amdgcn_readfirstlane(__float_as_uint(CLh[t0])));
    float offv; int nvalid;
    { const int cn = nq - 1 - lane; float pre = cn >= 0 ? CTh[cn] : 0.f;
#pragma unroll
      for (int o = 1; o < 64; o <<= 1) { const float up = __shfl_up(pre, o); if (lane >= o) pre += up; }
      const int kt = qb - 1 - lane, nk = kt >> 1, src = nq - 1 - nk;
      const float got = __shfl(pre, src < 0 ? 0 : src);
      offv = (kt >= 0 && src >= 0) ? got : 0.f;
      const float dmax = kt >= 0 ? cq0 + offv - CLh[32 * kt + 31] : -INFINITY;
      const unsigned long long stop = __ballot(dmax < -PRUNE || kt < 0);
      nvalid = stop ? (int)__builtin_ctzll(stop) : 64; }
    float mrun = -INFINITY, lsum = 0.f, offslow = 0.f;
    f32x16 oT[2];
#pragma unroll
    for (int i = 0; i < 16; ++i) { oT[0][i] = 0.f; oT[1][i] = 0.f; }
    bf16x8 kn_[4], vn_[2][2]; f32x4 cn_[4];
#define LOAD_TILE(k0_) do { const int kk0 = (k0_); \
        _Pragma("unroll") for (int ks = 0; ks < 4; ++ks) kn_[ks] = *(const bf16x8*)(KNh + (size_t)(kk0 + pir) * 512 + 16 * ks); \
        _Pragma("unroll") for (int blk = 0; blk < 2; ++blk) _Pragma("unroll") for (int s = 0; s < 2; ++s) vn_[blk][s] = *(const bf16x8*)(VTh + (size_t)(32 * blk) * SEQ + kk0 + 16 * s); \
        _Pragma("unroll") for (int s = 0; s < 2; ++s) { cn_[2 * s] = *(const f32x4*)(CLh + kk0 + 16 * s + 8 * hi); cn_[2 * s + 1] = *(const f32x4*)(CLh + kk0 + 16 * s + 8 * hi + 4); } } while (0)
    LOAD_TILE(t0);
    for (int kt = qb; kt >= 0; --kt) {
        float off = 0.f;
        if (kt != qb) {
            const int idx = qb - 1 - kt;
            if (idx < 64) { if (idx >= nvalid) break; off = __int_as_float(__builtin_amdgcn_readlane(__float_as_int(offv), idx)); offslow = off; }
            else {
                if (kt & 1) offslow += __uint_as_float(__builtin_amdgcn_readfirstlane(__float_as_uint(CTh[kt >> 1])));
                const float dmax = cq0 + offslow - __uint_as_float(__builtin_amdgcn_readfirstlane(__float_as_uint(CLh[32 * kt + 31])));
                if (dmax < -PRUNE) break;
                off = offslow; }
        }
        bf16x8 kf[4], vf[2][2]; f32x4 ck[4];
#pragma unroll
        for (int i = 0; i < 4; ++i) { kf[i] = kn_[i]; ck[i] = cn_[i]; }
        vf[0][0] = vn_[0][0]; vf[0][1] = vn_[0][1]; vf[1][0] = vn_[1][0]; vf[1][1] = vn_[1][1];
        if (kt > 0) LOAD_TILE(32 * (kt - 1));
        const float cb = cq + off;
        f32x16 sc;
#pragma unroll
        for (int i = 0; i < 16; ++i) sc[i] = cb;
#pragma unroll
        for (int ks = 0; ks < 4; ++ks) sc = MFMA32(kf[ks], qf[ks], sc);
        float mx = -INFINITY;
#pragma unroll
        for (int r = 0; r < 16; ++r) { const int kl = 16 * (r >> 3) + 8 * hi + (r & 7);
            float v = sc[r] - ck[r >> 2][r & 3];
            if (kt == qb && kl > r32) v = -INFINITY;
            sc[r] = v; mx = fmaxf(mx, v); }
        mx = fmaxf(mx, __shfl_xor(mx, 32));
        const float mnew = fmaxf(mrun, mx); const float alpha = __builtin_amdgcn_exp2f(mrun - mnew); mrun = mnew;
        float rs = 0.f;
#pragma unroll
        for (int r = 0; r < 16; ++r) { sc[r] = __builtin_amdgcn_exp2f(sc[r] - mnew); rs += sc[r]; }
        lsum = lsum * alpha + rs;
        if (__any(alpha != 1.0f)) {
#pragma unroll
            for (int i = 0; i < 16; ++i) { oT[0][i] *= alpha; oT[1][i] *= alpha; } }
        bf16x8 pb[2];
#pragma unroll
        for (int s = 0; s < 2; ++s) { u32x4 p; p.x = pk2(sc[8 * s], sc[8 * s + 1]); p.y = pk2(sc[8 * s + 2], sc[8 * s + 3]); p.z = pk2(sc[8 * s + 4], sc[8 * s + 5]); p.w = pk2(sc[8 * s + 6], sc[8 * s + 7]); pb[s] = __builtin_bit_cast(bf16x8, p); }
#pragma unroll
        for (int blk = 0; blk < 2; ++blk) { oT[blk] = MFMA32(vf[blk][0], pb[0], oT[blk]); oT[blk] = MFMA32(vf[blk][1], pb[1], oT[blk]); }
    }
#undef LOAD_TILE
    lsum += __shfl_xor(lsum, 32);
    const float inv = 1.0f / lsum;
    float ss = 0.f;
#pragma unroll
    for (int i = 0; i < 16; ++i) { oT[0][i] *= inv; oT[1][i] *= inv; ss += oT[0][i] * oT[0][i] + oT[1][i] * oT[1][i]; }
    ss += __shfl_xor(ss, 32);
    const float rstd = rsqrtf(ss * (1.f / 64.f) + EPS);
    const size_t rowoff = (size_t)(t0 + r32) * 512 + h * 64;
#pragma unroll
    for (int blk = 0; blk < 2; ++blk)
#pragma unroll
        for (int gi = 0; gi < 4; ++gi) { const int d = 32 * blk + 8 * gi + 4 * hi;
            const u32x2 z = *(const u32x2*)(FZ + rowoff + d); const f32x4 w = *(const f32x4*)(P.in[11] + d);
            const float z0 = bflo(z.x), z1 = bfhi(z.x), z2 = bflo(z.y), z3 = bfhi(z.y);
            u32x2 o; o.x = pk2(oT[blk][4 * gi] * rstd * w.x * z0 * sigmf(z0), oT[blk][4 * gi + 1] * rstd * w.y * z1 * sigmf(z1));
            o.y = pk2(oT[blk][4 * gi + 2] * rstd * w.z * z2 * sigmf(z2), oT[blk][4 * gi + 3] * rstd * w.w * z3 * sigmf(z3));
            *(u32x2*)(YB + rowoff + d) = o; }
}

#define BLK_BAR() asm volatile("s_waitcnt lgkmcnt(0)\n\ts_barrier" ::: "memory")
DI void fox_attn_blk(const Params& P, unsigned char* lds, LAS unsigned char* ldsl, int tid, int G, float PRUNE, int pir) {
    unsigned char* ws = P.ws;
    const int lane = tid & 63, wave = tid >> 6, r32 = lane & 31, hi = lane >> 5;
    const bf16_t* QN = (const bf16_t*)(ws + WS_PROJ) + 4 * BUF_ELEMS; const bf16_t* KN = (const bf16_t*)(ws + WS_PROJ) + 5 * BUF_ELEMS;
    const bf16_t* FZ = (const bf16_t*)(ws + WS_PROJ) + 7 * BUF_ELEMS; bf16_t* YB = (bf16_t*)(ws + WS_PROJ) + 1 * BUF_ELEMS;
    const bf16_t* VT = (const bf16_t*)(ws + WS_VT); const float* CL = (const float*)(ws + WS_CL); const float* CT = (const float*)(ws + WS_CT);
    const int h = (int)blockIdx.x & 7, bi = (int)blockIdx.x >> 3, nbh = G >> 3;
    const float* CLh = CL + (size_t)h * SEQ; const float* CTh = CT + h * 256;
    volatile int* nvs = (volatile int*)(lds + 12 * 10240);
    const int wvu = __builtin_amdgcn_readfirstlane(wave);
    const bool isk = tid < 256; const int sr = isk ? tid >> 3 : (tid - 256) >> 2, sl = isk ? tid & 7 : (tid - 256) & 3;
    const int scn = isk ? (sl ^ ((sr >> 1) & 7)) : (sl ^ ((sr >> 2) & 3));
    const bf16_t* gsrc = isk ? KN + (size_t)sr * 512 + h * 64 + 8 * scn : VT + (size_t)(h * 64 + sr) * SEQ + 8 * scn;
    const size_t gstep = isk ? (size_t)32 * 512 : (size_t)32;
    const int koff = pir * 128, ksw = (pir >> 1) & 7, voff = 4096 + r32 * 64, vsw = (r32 >> 2) & 3;
    for (int grp = bi; grp < 64; grp += nbh) {
        const int QB0 = grp * 8, qb = QB0 + wave, t0 = qb * 32, nq = qb >> 1;
        bf16x8 qf[4];
#pragma unroll
        for (int ks = 0; ks < 4; ++ks) qf[ks] = *(const bf16x8*)(QN + (size_t)(t0 + r32) * 512 + h * 64 + 16 * ks + 8 * hi);
        const float cq = CLh[t0 + r32];
        const float cq0 = __uint_as_float(__builtin_amdgcn_readfirstlane(__float_as_uint(CLh[t0])));
        float offv; int nvalid;
        { const int cn = nq - 1 - lane; float pre = cn >= 0 ? CTh[cn] : 0.f;
          const int kt = qb - 1 - lane; const float clen = kt >= 0 ? CLh[32 * kt + 31] : 0.f;
#pragma unroll
          for (int o = 1; o < 64; o <<= 1) { const float up = __shfl_up(pre, o); if (lane >= o) pre += up; }
          const int nk = kt >> 1, src = nq - 1 - nk;
          const float got = __shfl(pre, src < 0 ? 0 : src);
          offv = (kt >= 0 && src >= 0) ? got : 0.f;
          const float dmax = kt >= 0 ? cq0 + offv - clen : -INFINITY;
          const unsigned long long stop = __ballot(dmax < -PRUNE || kt < 0);
          nvalid = stop ? (int)__builtin_ctzll(stop) : 64; }
        const size_t rowoff = (size_t)(t0 + r32) * 512 + h * 64;
        if (lane == 0) nvs[wave] = nvalid;
        BLK_BAR();
        int nvmax = 0;
#pragma unroll
        for (int w_ = 0; w_ < 8; ++w_) { const int v_ = nvs[w_]; nvmax = v_ > nvmax ? v_ : nvmax; }
        nvmax = __builtin_amdgcn_readfirstlane(nvmax);
        if (nvmax >= 56) {
            BLK_BAR();
            fox_attn_unit(P, tid, h, qb, PRUNE, pir);
            continue; }
#define DMA_TILE(kt_) do { const int ku_ = (kt_), kc_ = ku_ > 0 ? ku_ : 0, b_ = (ku_ + 120) % 12; \
            __builtin_amdgcn_global_load_lds((const unsigned*)(gsrc + (size_t)kc_ * gstep), (LAS unsigned*)(ldsl + b_ * 10240 + wvu * 1024), 16, 0, 0); \
            __builtin_amdgcn_global_load_lds((const unsigned*)(CLh + 32 * kc_ + lane), (LAS unsigned*)(ldsl + b_ * 10240 + 8192 + wvu * 256), 4, 0, 0); } while (0)
        for (int j_ = 0; j_ < 11; ++j_) DMA_TILE(QB0 + 7 - j_);
        asm volatile("s_waitcnt vmcnt(6)" ::: "memory");
        float mrun = -INFINITY, lsum = 0.f;
        f32x16 oT[2];
#pragma unroll
        for (int i = 0; i < 16; ++i) { oT[0][i] = 0.f; oT[1][i] = 0.f; }
        BLK_BAR();
        const bool stag = wvu >= 4; bool pend = false;
        f32x16 sc; bf16x8 vf[2][2]; float alpha = 1.f;
#pragma unroll
        for (int i = 0; i < 16; ++i) sc[i] = 0.f;
        vf[0][0] = vf[0][1] = vf[1][0] = vf[1][1] = (bf16x8){0, 0, 0, 0, 0, 0, 0, 0};
#define ATT_TAIL() do { float rs = 0.f; \
            _Pragma("unroll") for (int r = 0; r < 16; ++r) rs += sc[r]; \
            lsum = lsum * alpha + rs; \
            if (__any(alpha != 1.0f)) { _Pragma("unroll") for (int i = 0; i < 16; ++i) { oT[0][i] *= alpha; oT[1][i] *= alpha; } } \
            bf16x8 pb[2]; \
            _Pragma("unroll") for (int s = 0; s < 2; ++s) { u32x4 p; p.x = pk2(sc[8 * s], sc[8 * s + 1]); p.y = pk2(sc[8 * s + 2], sc[8 * s + 3]); p.z = pk2(sc[8 * s + 4], sc[8 * s + 5]); p.w = pk2(sc[8 * s + 6], sc[8 * s + 7]); pb[s] = __builtin_bit_cast(bf16x8, p); } \
            _Pragma("unroll") for (int blk = 0; blk < 2; ++blk) { oT[blk] = MFMA32(vf[blk][0], pb[0], oT[blk]); oT[blk] = MFMA32(vf[blk][1], pb[1], oT[blk]); } } while (0)
        for (int it = 0; it <= nvmax; ++it) {
            if (pend) { ATT_TAIL(); pend = false; }
            DMA_TILE(QB0 - it - 4);
            const int kt = qb - it;
            if (it <= nvalid) {
                const unsigned char* tb = lds + ((kt + 120) % 12) * 10240;
                const float off = it == 0 ? 0.f : __int_as_float(__builtin_amdgcn_readlane(__float_as_int(offv), it - 1));
                bf16x8 kf[4]; f32x4 ck[4];
#pragma unroll
                for (int ks = 0; ks < 4; ++ks) kf[ks] = *(const bf16x8*)(tb + koff + (((2 * ks + hi) ^ ksw) << 4));
#pragma unroll
                for (int blk = 0; blk < 2; ++blk)
#pragma unroll
                    for (int s = 0; s < 2; ++s) vf[blk][s] = *(const bf16x8*)(tb + voff + blk * 2048 + (((2 * s + hi) ^ vsw) << 4));
#pragma unroll
                for (int s = 0; s < 2; ++s) { ck[2 * s] = *(const f32x4*)(tb + 8192 + wvu * 256 + (16 * s + 8 * hi) * 4); ck[2 * s + 1] = *(const f32x4*)(tb + 8192 + wvu * 256 + (16 * s + 8 * hi) * 4 + 16); }
                const float cb = cq + off;
#pragma unroll
                for (int i = 0; i < 16; ++i) sc[i] = cb;
#pragma unroll
                for (int ks = 0; ks < 4; ++ks) sc = MFMA32(kf[ks], qf[ks], sc);
                float mx = -INFINITY;
#pragma unroll
                for (int r = 0; r < 16; ++r) { const int kl = 16 * (r >> 3) + 8 * hi + (r & 7);
                    float v = sc[r] - ck[r >> 2][r & 3];
                    if (kt == qb && kl > r32) v = -INFINITY;
                    sc[r] = v; mx = fmaxf(mx, v); }
                { const auto rr = __builtin_amdgcn_permlane32_swap(__float_as_uint(mx), __float_as_uint(mx), false, false);
                  mx = fmaxf(__uint_as_float(rr[0]), __uint_as_float(rr[1])); }
                const float mnew = fmaxf(mrun, mx); alpha = __builtin_amdgcn_exp2f(mrun - mnew); mrun = mnew;
#pragma unroll
                for (int r = 0; r < 16; ++r) sc[r] = __builtin_amdgcn_exp2f(sc[r] - mnew);
                if (stag) pend = true; else ATT_TAIL();
            }
            asm volatile("s_waitcnt vmcnt(6)" ::: "memory");
            BLK_BAR();
        }
        if (pend) { ATT_TAIL(); pend = false; }
#undef ATT_TAIL
#undef DMA_TILE
        { const auto rr = __builtin_amdgcn_permlane32_swap(__float_as_uint(lsum), __float_as_uint(lsum), false, false); lsum = __uint_as_float(rr[0]) + __uint_as_float(rr[1]); }
        const float inv = 1.0f / lsum;
        float ss = 0.f;
#pragma unroll
        for (int i = 0; i < 16; ++i) { oT[0][i] *= inv; oT[1][i] *= inv; ss += oT[0][i] * oT[0][i] + oT[1][i] * oT[1][i]; }
        { const auto rr = __builtin_amdgcn_permlane32_swap(__float_as_uint(ss), __float_as_uint(ss), false, false); ss = __uint_as_float(rr[0]) + __uint_as_float(rr[1]); }
        const float rstd = rsqrtf(ss * (1.f / 64.f) + EPS);
#pragma unroll
        for (int blk = 0; blk < 2; ++blk)
#pragma unroll
            for (int gi = 0; gi < 4; ++gi) { const int d = 32 * blk + 8 * gi + 4 * hi;
                const u32x2 z = *(const u32x2*)(FZ + rowoff + d); const f32x4 w = *(const f32x4*)(P.in[11] + d);
                const float z0 = bflo(z.x), z1 = bfhi(z.x), z2 = bflo(z.y), z3 = bfhi(z.y);
                u32x2 o; o.x = pk2(oT[blk][4 * gi] * rstd * w.x * z0 * sigmf(z0), oT[blk][4 * gi + 1] * rstd * w.y * z1 * sigmf(z1));
                o.y = pk2(oT[blk][4 * gi + 2] * rstd * w.z * z2 * sigmf(z2), oT[blk][4 * gi + 3] * rstd * w.w * z3 * sigmf(z3));
                *(u32x2*)(YB + rowoff + d) = o; }
    }
}

DI void fox_attn(const Params& P, unsigned char* lds, LAS unsigned char* ldsl, int tid, int G) {
    const int lane = tid & 63, wave = tid >> 6, r32 = lane & 31;
    const float bq = wave_max(fabsf(P.in[9][lane])), bk = wave_max(fabsf(P.in[10][lane]));
    const float PRUNE = (2.f * 8.f * bq * bk + 30.f) * 1.4426950408889634f;
    const int pir = (r32 & ~12) | ((r32 & 4) << 1) | ((r32 & 8) >> 1);
    if ((G & 7) == 0) { fox_attn_blk(P, lds, ldsl, tid, G, PRUNE, pir); return; }
    const int nwaves = G * 8, gw = (int)blockIdx.x * 8 + wave;
    for (int u = gw; u < 4096; u += nwaves) fox_attn_unit(P, tid, u & 7, u >> 3, PRUNE, pir);
}

#define XB_TMO      128
#define XB_XCNT(j)  (256  + 64 * (j))
#define XB_XSUB(j)  (1280 + 64 * (j))
#define XB_XGEN(j)  (2304 + 64 * (j))
#define XB_TOP      3328
#define XB_TOPGEN   3392
#define XCD_BAR_WORDS 3456
#define XB_SPIN_CAP (1u << 18)
__device__ __forceinline__ unsigned xb_ld(unsigned* p)              { return __hip_atomic_load(p, __ATOMIC_RELAXED, __HIP_MEMORY_SCOPE_AGENT); }
__device__ __forceinline__ unsigned xb_add(unsigned* p, unsigned v) { return __hip_atomic_fetch_add(p, v, __ATOMIC_RELAXED, __HIP_MEMORY_SCOPE_AGENT); }
__device__ __forceinline__ unsigned xb_xcc_id() { return (unsigned)__builtin_amdgcn_s_getreg((3 << 11) | 20) & 0xFu; }
#define XB_SPIN(cond, bar) do { unsigned _sp = 0; while (cond) { __builtin_amdgcn_s_sleep(1); \
    if ((++_sp & 255u) == 0u) { if (xb_ld(&(bar)[XB_TMO])) break; if (_sp > XB_SPIN_CAP) { atomicAdd(&(bar)[XB_TMO], 1u); break; } } } } while (0)
struct XcdBarrier { unsigned* bar; unsigned x; volatile LAS unsigned* st; };
__device__ __forceinline__ XcdBarrier xcd_barrier_post(unsigned* bar, volatile LAS unsigned* st) {
    XcdBarrier b; b.bar = bar; b.x = xb_xcc_id(); b.st = st;
    if (threadIdx.x == 0) (void)xb_add(&bar[XB_XCNT(b.x)], 1u);
    return b;
}
__device__ __forceinline__ void xcd_barrier_complete(unsigned* bar, unsigned x, unsigned& nloc, unsigned& nx) {
    const unsigned G = gridDim.x * gridDim.y * gridDim.z;
    unsigned sum, cnt, mine, sp = 0u;
    for (;;) {
        sum = 0u; cnt = 0u; mine = 0u;
#pragma unroll
        for (unsigned j = 0; j < 16; ++j) { const unsigned c = xb_ld(&bar[XB_XCNT(j)]); sum += c; cnt += (c > 0u) ? 1u : 0u; mine = (j == x) ? c : mine; }
        if (sum == G) break;
        __builtin_amdgcn_s_sleep(1);
        if ((++sp & 255u) == 0u) { if (xb_ld(&bar[XB_TMO])) break; if (sp > XB_SPIN_CAP) { atomicAdd(&bar[XB_TMO], 1u); break; } }
    }
    nloc = mine > 0u ? mine : 1u; nx = cnt > 0u ? cnt : 1u;
}
__device__ __forceinline__ void xcd_barrier(const XcdBarrier& b) {
    asm volatile("s_waitcnt vmcnt(0)" ::: "memory");
    __syncthreads();
    if (threadIdx.x == 0) {
        unsigned* bar = b.bar;
        __builtin_amdgcn_s_waitcnt(0);
        unsigned nloc = b.st[0], nx = b.st[1];
        if (nloc == 0u) { xcd_barrier_complete(bar, b.x, nloc, nx); b.st[0] = nloc; b.st[1] = nx; }
        const unsigned old = xb_add(&bar[XB_XSUB(b.x)], 1u);
        const unsigned gen = old / nloc;
        if (old + 1u == (gen + 1u) * nloc) {
            __builtin_amdgcn_fence(__ATOMIC_RELEASE, "agent");
            asm volatile("s_waitcnt vmcnt(0)" ::: "memory");
            const unsigned og = xb_add(&bar[XB_TOP], 1u);
            const unsigned tg = og / nx;
            if (og + 1u == (tg + 1u) * nx) xb_add(&bar[XB_TOPGEN], 1u);
            else XB_SPIN(xb_ld(&bar[XB_TOPGEN]) == tg, bar);
            __builtin_amdgcn_fence(__ATOMIC_ACQUIRE, "agent");
            xb_add(&bar[XB_XGEN(b.x)], 1u);
            asm volatile("s_waitcnt vmcnt(0)" ::: "memory");
        } else {
            XB_SPIN(xb_ld(&bar[XB_XGEN(b.x)]) == gen, bar);
            __builtin_amdgcn_fence(__ATOMIC_ACQUIRE, "agent");
            asm volatile("s_waitcnt vmcnt(0)" ::: "memory");
        }
    }
    __syncthreads();
}

__global__ void __launch_bounds__(512, 2) mega_fwd(Params P) {
    extern __shared__ __attribute__((aligned(16))) unsigned char lds[];
    cg::grid_group grid = cg::this_grid();
    const int tid = threadIdx.x, G = gridDim.x;
    unsigned char* ws = P.ws;
    LAS unsigned char* ldsl = (LAS unsigned char*)lds;
    volatile LAS unsigned* bst = (volatile LAS unsigned*)(ldsl + 151040);
    if (tid < 2) bst[tid] = 0u;
    __syncthreads();
    const XcdBarrier bar = xcd_barrier_post((unsigned*)(ws + WS_BAR), bst);

    phase0(P, lds, tid, G);
    if ((G & 7) == 0) xcd_barrier(bar); else grid.sync();

    { pg8::Gemm g{(const bf16_t*)(ws + WS_H), (const bf16_t*)(ws + WS_WIN), SEQ, NMAIN, 1024}; pg8::StaticOrder S; S.init(SEQ, NMAIN, G, (int)blockIdx.x);
      pg8::EpiSplitBf16 E{(bf16_t*)(ws + WS_PROJ), BUF_ELEMS};
      pg8::gemm_phase<pg8::EpiSplitBf16, pg8::StaticOrder, true, true>(ldsl, g, S, E);
      small_proj(P, lds, tid, G);
 }
    if ((G & 7) == 0) xcd_barrier(bar); else grid.sync();

    if (G == 256) {
      const int hb = (int)blockIdx.x & 7, gb = (int)blockIdx.x >> 3;
      { u32x4 raw[12]; float sbv = 0.f, sav = 0.f;
        gdn_load(P, (8 * gb) * 8 + hb, tid, raw, sbv, sav);
        for (int i = tid; i < 768; i += 512) { const int j = i / 192, r = i % 192; ((float*)(lds + 86016))[i] = P.in[4][j * 1536 + (r >> 6) * 512 + hb * 64 + (r & 63)]; }
        __syncthreads();
        for (int k = 0; k < 8; ++k) gdn_prep_unit(P, hb, 8 * gb + k, lds, tid, raw, sbv, sav, k < 7 ? (8 * gb + k + 1) * 8 + hb : -1, true); }
      __syncthreads();
      gdn_scan<true>(P, hb, gb, lds, ldsl, tid);
      __syncthreads();
      for (int n = blockIdx.x; n < 256; n += G) fox_prep_unit(P, n, lds, tid);
      if ((G & 7) == 0) xcd_barrier(bar); else grid.sync();
    } else {
      { u32x4 raw[12]; float sbv = 0.f, sav = 0.f;
        if ((int)blockIdx.x < 2048) gdn_load(P, (int)blockIdx.x, tid, raw, sbv, sav);
        for (int u = blockIdx.x; u < 2048; u += G) gdn_prep_unit(P, u & 7, u >> 3, lds, tid, raw, sbv, sav, u + G < 2048 ? u + G : -1);
        __syncthreads(); }
      for (int n = blockIdx.x; n < 256; n += G) fox_prep_unit(P, n, lds, tid);
      if ((G & 7) == 0) xcd_barrier(bar); else grid.sync();
      for (int u = blockIdx.x; u < 256; u += G) { gdn_scan<true>(P, u & 7, u >> 3, lds, ldsl, tid); __syncthreads(); }
      if ((G & 7) == 0) xcd_barrier(bar); else grid.sync();
    }
    for (int u = blockIdx.x; u < 256; u += G) { gdn_scan<false>(P, u & 7, u >> 3, lds, ldsl, tid); __syncthreads(); }
    fox_attn(P, lds, ldsl, tid, G);
    if ((G & 7) == 0) xcd_barrier(bar); else grid.sync();

    { pg8::StaticOrder S; S.init(SEQ, 1024, G, (int)blockIdx.x);
      bf16_t* Mo = (bf16_t*)(ws + WS_PROJ) + 2 * BUF_ELEMS;
      { pg8::Gemm g{(const bf16_t*)(ws + WS_PROJ), (const bf16_t*)(ws + WS_WUPA), SEQ, 1024, 512};
        pg8::EpiGate E{Mo, (const bf16_t*)(ws + WS_PROJ) + 8 * BUF_ELEMS, BUF_ELEMS, P.in[3], 0};
        pg8::gemm_phase<pg8::EpiGate, pg8::StaticOrder, true, true>(ldsl, g, S, E); }
      __syncthreads();
      { pg8::Gemm g{(const bf16_t*)(ws + WS_PROJ) + BUF_ELEMS, (const bf16_t*)(ws + WS_WUPB), SEQ, 1024, 512};
        pg8::EpiGate E{Mo, (const bf16_t*)(ws + WS_PROJ) + 10 * BUF_ELEMS, BUF_ELEMS, P.in[3] + 1024, 1};
        pg8::gemm_phase<pg8::EpiGate, pg8::StaticOrder, true, true>(ldsl, g, S, E); } }
    if ((G & 7) == 0) xcd_barrier(bar); else grid.sync();

    if (G == 256) {
      pg8::StaticOrder S; S.init(SEQ, 1024, G, (int)blockIdx.x);
      pg8::Gemm g{(const bf16_t*)(ws + WS_PROJ) + 2 * BUF_ELEMS, (const bf16_t*)(ws + WS_WOUT), SEQ, 1024, 1024};
      pg8::EpiResNorm E{P.in[0], P.out, P.in[15], (float*)(ws + WS_XB), (unsigned*)(ws + WS_PCNT), EPS};
      pg8::gemm_phase<pg8::EpiResNorm, pg8::StaticOrder, false, true>(ldsl, g, S, E);
    } else {
      { pg8::StaticOrder S; S.init(SEQ, 1024, G, (int)blockIdx.x);
        pg8::Gemm g{(const bf16_t*)(ws + WS_PROJ) + 2 * BUF_ELEMS, (const bf16_t*)(ws + WS_WOUT), SEQ, 1024, 1024};
        pg8::EpiRes E{P.in[0], P.out};
        pg8::gemm_phase<pg8::EpiRes, pg8::StaticOrder, true, true>(ldsl, g, S, E); }
      if ((G & 7) == 0) xcd_barrier(bar); else grid.sync();
      { const int lane = tid & 63, wave = tid >> 6, gw = blockIdx.x * 8 + wave, NGW = G * 8;
        const float* fw = P.in[15]; f32x4 wv[4];
#pragma unroll
        for (int j = 0; j < 4; ++j) wv[j] = *(const f32x4*)(fw + 4 * lane + 256 * j);
        for (int m = gw; m < SEQ; m += NGW) {
            f32x4* xr = (f32x4*)(P.out + (size_t)m * DM) + lane; f32x4 v[4]; float s = 0.f;
#pragma unroll
            for (int j = 0; j < 4; ++j) { v[j] = xr[64 * j]; s += (v[j].x * v[j].x + v[j].y * v[j].y) + (v[j].z * v[j].z + v[j].w * v[j].w); }
            const float rstd = rsqrtf(wave_sum(s) * (1.f / DM) + EPS);
#pragma unroll
            for (int j = 0; j < 4; ++j) xr[64 * j] = v[j] * rstd * wv[j];
        } }
    }
}

extern "C" void kernel_launch(void* const* d_in, const int* in_sizes, int n_in, void* d_out, int out_size, void* d_ws, size_t ws_size, hipStream_t stream) {
    static int grid = 0;
    if (grid == 0) {
        if (n_in != 16 || out_size != SEQ * DM || ws_size < WS_END) { fprintf(stderr, "kernel_launch: unexpected shapes (n_in %d out %d ws %zu)\n", n_in, out_size, ws_size); grid = -1; return; }
        int dev = 0, cus = 0, per_cu = 0;
        hipGetDevice(&dev); hipDeviceGetAttribute(&cus, hipDeviceAttributeMultiprocessorCount, dev);
        if (hipFuncSetAttribute((const void*)mega_fwd, hipFuncAttributeMaxDynamicSharedMemorySize, LDS_BYTES) != hipSuccess) { fprintf(stderr, "hipFuncSetAttribute failed\n"); grid = -1; return; }
        if (hipOccupancyMaxActiveBlocksPerMultiprocessor(&per_cu, (const void*)mega_fwd, 512, LDS_BYTES) != hipSuccess || per_cu < 1) { fprintf(stderr, "occupancy query failed (%d)\n", per_cu); grid = -1; return; }
        grid = cus;
        if (grid < 16) { grid = -1; return; }
    }
    if (grid < 0) return;
    if (hipMemsetAsync((char*)d_ws + WS_BAR, 0, 32768, stream) != hipSuccess) { fprintf(stderr, "memset failed\n"); return; }
    Params p{};
    for (int i = 0; i < 16; ++i) p.in[i] = (const float*)d_in[i];
    p.out = (float*)d_out; p.ws = (unsigned char*)d_ws;
    void* args[] = {&p};
    hipError_t e = hipLaunchCooperativeKernel((const void*)mega_fwd, dim3(grid), dim3(512), args, LDS_BYTES, stream);
    if (e != hipSuccess) fprintf(stderr, "cooperative launch failed: %s (grid %d)\n", hipGetErrorString(e), grid);
}
```

```cpp
#include <hip/hip_runtime.h>
#include <hip/hip_cooperative_groups.h>
#include <cstdio>
#include <cstdint>
namespace cg = cooperative_groups;

#define DI __device__ __forceinline__
namespace pg8 {
#define PG8_LAS __attribute__((address_space(3)))
typedef unsigned short bf16_t;
typedef short bf16x8 __attribute__((ext_vector_type(8)));
typedef float f32x4 __attribute__((ext_vector_type(4)));
typedef unsigned u32x4 __attribute__((ext_vector_type(4)));
constexpr int BM = 256, BK = 64, HALF = 128, HTB = HALF * BK * 2, STAGE_BYTES = 8 * HTB, NXCD = 8, WGM = 8;

__host__ __device__ __forceinline__ int lds_byte(int r, int c) { const int st = (r >> 4) * 2 + (c >> 5), rr = r & 15, cc = c & 31, ob = rr * 64 + cc * 2; return st * 1024 + (ob ^ (((ob >> 9) & 1) << 5)); }
__host__ __device__ __forceinline__ void stage_rc(int b, int& R, int& C) { const int st = b / 1024, sb = b % 1024, swz = sb ^ (((sb >> 9) & 1) << 5); R = (st >> 1) * 16 + swz / 64; C = (st & 1) * 32 + (swz % 64) / 2; }
__host__ __device__ __forceinline__ int perm32(int rho) { const int n = rho >> 4, i = rho & 15; return 8 * (i >> 2) + 4 * n + (i & 3); }

struct Unit { int pm, pn; };
struct Gemm { const bf16_t* A; const bf16_t* Bt; int M, N, K; };

struct StaticOrder {
    int nM, nN, nwg, G, c;
    __host__ __device__ void init(int M, int N, int G_, int c_) { nM = M / BM; nN = N / BM; nwg = nM * nN; G = G_; c = c_; }
    __host__ __device__ bool next(int i, Unit& u) const {
        const long L = (long)i * G + c; if (L >= nwg) return false;
        int wgid = (int)L; { const int q = nwg / NXCD, r = nwg % NXCD, xcd = wgid % NXCD, off = wgid / NXCD; wgid = (xcd < r ? xcd * (q + 1) : r * (q + 1) + (xcd - r) * q) + off; }
        const int nig = WGM * nN, gid = wgid / nig, fm = gid * WGM, gsz = (nM - fm) < WGM ? (nM - fm) : WGM;
        u.pm = fm + ((wgid % nig) % gsz); u.pn = (wgid % nig) / gsz; return true;
    }
    __device__ __forceinline__ void a_ready(const Unit&) const {}
    __device__ __forceinline__ void done(const Unit&) const {}
};

__device__ __forceinline__ unsigned cvt_pk_bf16(float lo, float hi) { unsigned r; asm volatile("v_cvt_pk_bf16_f32 %0, %1, %2" : "=v"(r) : "v"(lo), "v"(hi)); return r; }
__device__ __forceinline__ float bflo(unsigned u) { return __uint_as_float(u << 16); }
__device__ __forceinline__ float bfhi(unsigned u) { return __uint_as_float(u & 0xffff0000u); }
__device__ __forceinline__ float sigm(float v) { return __builtin_amdgcn_rcpf(1.0f + __expf(-v)); }

struct EpiSplitBf16 {
    static constexpr bool PERM = true, AFTER_DRAIN = false;
    bf16_t* O; size_t split_stride;
    __device__ __forceinline__ void operator()(const f32x4 (&acc)[2][2][4][2], const Unit& u, int wr, int wc, int fr, int fq) const {
        const int row0 = u.pm * BM + wr * 64 + fr; int colt = u.pn * BM; const int t = colt / 512; bf16_t* base = O + (size_t)t * split_stride; colt -= t * 512;
        const int col0 = colt + wc * 32 + 8 * fq;
#pragma unroll
        for (int ai = 0; ai < 2; ++ai)
#pragma unroll
            for (int m = 0; m < 4; ++m) { bf16_t* rowp = base + (size_t)(row0 + ai * HALF + m * 16) * 512 + col0;
#pragma unroll
                for (int bj = 0; bj < 2; ++bj) { const f32x4 v0 = acc[ai][bj][m][0], v1 = acc[ai][bj][m][1];
                    u32x4 w; w.x = cvt_pk_bf16(v0[0], v0[1]); w.y = cvt_pk_bf16(v0[2], v0[3]); w.z = cvt_pk_bf16(v1[0], v1[1]); w.w = cvt_pk_bf16(v1[2], v1[3]);
                    *(u32x4*)(rowp + bj * HALF) = w; } }
    }
};
struct EpiGate {
    static constexpr bool PERM = true, AFTER_DRAIN = false;
    bf16_t* Mo; const bf16_t* G0; size_t split_stride; const float* gb; int accum;
    __device__ __forceinline__ void operator()(const f32x4 (&acc)[2][2][4][2], const Unit& u, int wr, int wc, int fr, int fq) const {
        const int row0 = u.pm * BM + wr * 64 + fr; const int colt = u.pn * BM; const int t = colt / 512;
        const bf16_t* gbase = G0 + (size_t)t * split_stride; const int col0 = colt + wc * 32 + 8 * fq, gcol0 = col0 - t * 512;
#pragma unroll
        for (int bj = 0; bj < 2; ++bj) {
            const f32x4 b0 = *(const f32x4*)(gb + col0 + bj * HALF), b1 = *(const f32x4*)(gb + col0 + bj * HALF + 4);
#pragma unroll
            for (int ai = 0; ai < 2; ++ai)
#pragma unroll
                for (int m = 0; m < 4; ++m) { const size_t row = (size_t)(row0 + ai * HALF + m * 16);
                    const u32x4 g = *(const u32x4*)(gbase + row * 512 + gcol0 + bj * HALF);
                    const f32x4 v0 = acc[ai][bj][m][0], v1 = acc[ai][bj][m][1];
                    float r0 = v0[0] * sigm(bflo(g.x) + b0[0]), r1 = v0[1] * sigm(bfhi(g.x) + b0[1]), r2 = v0[2] * sigm(bflo(g.y) + b0[2]), r3 = v0[3] * sigm(bfhi(g.y) + b0[3]);
                    float r4 = v1[0] * sigm(bflo(g.z) + b1[0]), r5 = v1[1] * sigm(bfhi(g.z) + b1[1]), r6 = v1[2] * sigm(bflo(g.w) + b1[2]), r7 = v1[3] * sigm(bfhi(g.w) + b1[3]);
                    bf16_t* op = Mo + row * 1024 + col0 + bj * HALF;
                    if (accum) { const u32x4 p = *(const u32x4*)op; r0 += bflo(p.x); r1 += bfhi(p.x); r2 += bflo(p.y); r3 += bfhi(p.y); r4 += bflo(p.z); r5 += bfhi(p.z); r6 += bflo(p.w); r7 += bfhi(p.w); }
                    u32x4 w; w.x = cvt_pk_bf16(r0, r1); w.y = cvt_pk_bf16(r2, r3); w.z = cvt_pk_bf16(r4, r5); w.w = cvt_pk_bf16(r6, r7);
                    *(u32x4*)op = w; }
        }
    }
};
struct EpiRes {
    static constexpr bool PERM = false, AFTER_DRAIN = false;
    const float* base; float* out;
    __device__ __forceinline__ void operator()(const f32x4 (&acc)[2][2][4][2], const Unit& u, int wr, int wc, int fr, int fq) const {
        const int col0 = u.pn * BM + wc * 32 + 4 * fq;
#pragma unroll
        for (int ai = 0; ai < 2; ++ai)
#pragma unroll
            for (int m = 0; m < 4; ++m) { const size_t off = (size_t)(u.pm * BM + ai * HALF + wr * 64 + m * 16 + fr) * 1024 + col0;
#pragma unroll
                for (int bj = 0; bj < 2; ++bj)
#pragma unroll
                    for (int n = 0; n < 2; ++n) { const f32x4 bs = *(const f32x4*)(base + off + bj * HALF + n * 16); *(f32x4*)(out + off + bj * HALF + n * 16) = bs + acc[ai][bj][m][n]; } }
    }
};

struct EpiResNorm {
    static constexpr bool PERM = false, AFTER_DRAIN = true;
    const float* base; float* out; const float* fw; float* xbuf; unsigned* cnt; float eps;
    __device__ __forceinline__ void fused(f32x4 (&acc)[2][2][4][2], const Unit& u, int wr, int wc, int fr, int fq, PG8_LAS unsigned char* lds, int wid, int lane) const {
        PG8_LAS float* Pp = (PG8_LAS float*)lds;
        PG8_LAS float* Sr = (PG8_LAS float*)(lds + 4096);
        const int col0 = u.pn * BM + wc * 32 + 4 * fq;
#pragma unroll
        for (int ai = 0; ai < 2; ++ai)
#pragma unroll
            for (int m = 0; m < 4; ++m) { const int rl = ai * HALF + wr * 64 + m * 16 + fr; const size_t off = (size_t)(u.pm * BM + rl) * 1024 + col0; float s = 0.f;
#pragma unroll
                for (int bj = 0; bj < 2; ++bj)
#pragma unroll
                    for (int n = 0; n < 2; ++n) { const f32x4 xv = *(const f32x4*)(base + off + bj * HALF + n * 16); f32x4 v = acc[ai][bj][m][n] + xv; acc[ai][bj][m][n] = v;
                        s += (v[0] * v[0] + v[1] * v[1]) + (v[2] * v[2] + v[3] * v[3]); }
                s += __shfl_xor(s, 16); s += __shfl_xor(s, 32);
                if (fq == 0) Pp[rl * 4 + wc] = s; }
        asm volatile("s_waitcnt lgkmcnt(0)" ::: "memory"); __builtin_amdgcn_s_barrier(); asm volatile("" ::: "memory");
        const int row = wid * 32 + (lane & 31);
        if (lane < 32) { const float tot = (Pp[row * 4 + 0] + Pp[row * 4 + 1]) + (Pp[row * 4 + 2] + Pp[row * 4 + 3]);
            __hip_atomic_store(xbuf + (size_t)(u.pm * BM + row) * 4 + u.pn, tot, __ATOMIC_RELAXED, __HIP_MEMORY_SCOPE_AGENT); }
        asm volatile("s_waitcnt vmcnt(0)" ::: "memory");
        if (lane == 0) __hip_atomic_fetch_add(cnt + 64 * u.pm, 1u, __ATOMIC_RELAXED, __HIP_MEMORY_SCOPE_AGENT);
        if (wid == 0) {
            unsigned sp = 0;
            for (;;) { if ((unsigned)__builtin_amdgcn_readfirstlane(__hip_atomic_load(cnt + 64 * u.pm, __ATOMIC_RELAXED, __HIP_MEMORY_SCOPE_AGENT)) >= 32u) break;
                if (++sp > (1u << 20)) break; __builtin_amdgcn_s_sleep(2); }
            __builtin_amdgcn_fence(__ATOMIC_ACQUIRE, "agent");
        }
        asm volatile("s_waitcnt vmcnt(0) lgkmcnt(0)" ::: "memory"); __builtin_amdgcn_s_barrier(); asm volatile("" ::: "memory");
        if (lane < 32) { const float* slot = xbuf + (size_t)(u.pm * BM + row) * 4; float tot = 0.f;
#pragma unroll
            for (int t = 0; t < 4; ++t) tot += __hip_atomic_load(slot + t, __ATOMIC_RELAXED, __HIP_MEMORY_SCOPE_AGENT);
            Sr[row] = rsqrtf(tot * (1.0f / 1024.0f) + eps); }
        asm volatile("s_waitcnt lgkmcnt(0)" ::: "memory"); __builtin_amdgcn_s_barrier(); asm volatile("" ::: "memory");
#pragma unroll
        for (int bj = 0; bj < 2; ++bj)
#pragma unroll
            for (int n = 0; n < 2; ++n) { const f32x4 w4 = *(const f32x4*)(fw + col0 + bj * HALF + n * 16);
#pragma unroll
                for (int ai = 0; ai < 2; ++ai)
#pragma unroll
                    for (int m = 0; m < 4; ++m) { const int rl = ai * HALF + wr * 64 + m * 16 + fr; const float rs = Sr[rl];
                        *(f32x4*)(out + (size_t)(u.pm * BM + rl) * 1024 + col0 + bj * HALF + n * 16) = acc[ai][bj][m][n] * rs * w4; } }
    }
};

template <class Epi, class Sched, bool ALIGN_EPI = false, bool SP2 = false>
__device__ __forceinline__ void gemm_phase(PG8_LAS unsigned char* lds, const Gemm g, const Sched& S, const Epi& E) {
    int tid_ = threadIdx.x; asm volatile("" : "+v"(tid_));
    const int tid = tid_, wid = __builtin_amdgcn_readfirstlane(tid >> 6), lane = tid & 63, wr = wid >> 2, wc = wid & 3, fr = lane & 15, fq = lane >> 4;
    const int K = g.K, nt = K / BK;
    unsigned voffA[2], voffB[2];
#pragma unroll
    for (int i = 0; i < 2; ++i) { int R, C; stage_rc(tid * 16 + i * 8192, R, C); const int Rb = Epi::PERM ? ((R & ~31) + perm32(R & 31)) : R;
        voffA[i] = (unsigned)(R * K + C) * 2u; voffB[i] = (unsigned)(Rb * K + C) * 2u; }
    const size_t kstep = (size_t)(BK * 2);
    const size_t hstep = (size_t)HALF * K * 2;
    const size_t tstep = 2 * hstep;
    const unsigned ldsw = (unsigned)wid * 1024u;
    const int aoff = lds_byte(wr * 64 + fr, fq * 8), boff = lds_byte(wc * 32 + fr, fq * 8);
#define PG8_SA(b, h) (((b) * 2 + (h)) * HTB)
#define PG8_SB(b, h) ((4 + (b) * 2 + (h)) * HTB)
#define PG8_STAGE(bufoff, gbase, voff) do { _Pragma("unroll") for (int _i = 0; _i < 2; ++_i) \
        __builtin_amdgcn_global_load_lds((const unsigned*)((const char*)(gbase) + (voff)[_i]), (PG8_LAS unsigned*)(lds + (bufoff) + ldsw + _i * 8192), 16, 0, 0); } while (0)
#define PG8_LDA(dst, b, h) do { _Pragma("unroll") for (int m = 0; m < 4; ++m) _Pragma("unroll") for (int k = 0; k < 2; ++k) dst[m][k] = *(const PG8_LAS bf16x8*)(lds + PG8_SA(b, h) + aoff + m * 2048 + k * 1024); } while (0)
#define PG8_LDB(dst, b, h) do { _Pragma("unroll") for (int n = 0; n < 2; ++n) _Pragma("unroll") for (int k = 0; k < 2; ++k) dst[n][k] = *(const PG8_LAS bf16x8*)(lds + PG8_SB(b, h) + boff + n * 2048 + k * 1024); } while (0)
#define PG8_MMA(ai, bj, At, Bt) do { __builtin_amdgcn_s_setprio(1); _Pragma("unroll") for (int m = 0; m < 4; ++m) _Pragma("unroll") for (int n = 0; n < 2; ++n) _Pragma("unroll") for (int k = 0; k < 2; ++k) \
        acc[ai][bj][m][n] = __builtin_amdgcn_mfma_f32_16x16x32_bf16(Bt[n][k], At[m][k], acc[ai][bj][m][n], 0, 0, 0); __builtin_amdgcn_s_setprio(0); } while (0)
#define PG8_WAIT_V(n) asm volatile("s_waitcnt vmcnt(" #n ")" ::: "memory")
#define PG8_WAIT_L(n) asm volatile("s_waitcnt lgkmcnt(" #n ")" ::: "memory")
#define PG8_BAR __builtin_amdgcn_s_barrier()
#define PG8_SCHED __builtin_amdgcn_sched_barrier(0)
    Unit cur, nxt; int ui = 0;
    if (!S.next(0, cur)) return;
    f32x4 acc[2][2][4][2];
#pragma unroll
    for (int a = 0; a < 2; ++a)
#pragma unroll
        for (int b = 0; b < 2; ++b)
#pragma unroll
            for (int m = 0; m < 4; ++m)
#pragma unroll
                for (int n = 0; n < 2; ++n) acc[a][b][m][n] = (f32x4){0.f, 0.f, 0.f, 0.f};
    bf16x8 At[4][2], B0[2][2], B1[2][2];
    const char* cA = (const char*)g.A + (size_t)cur.pm * tstep; const char* cB = (const char*)g.Bt + (size_t)cur.pn * tstep;
    S.a_ready(cur);
    if constexpr (SP2) {
        PG8_STAGE(PG8_SB(0, 0), cB, voffB); PG8_STAGE(PG8_SB(0, 1), cB + hstep, voffB); PG8_STAGE(PG8_SA(0, 0), cA, voffA); PG8_STAGE(PG8_SA(0, 1), cA + hstep, voffA);
        if (wr == 1) PG8_BAR;
        PG8_WAIT_V(2); PG8_BAR;
        PG8_STAGE(PG8_SB(1, 0), cB + kstep, voffB); PG8_STAGE(PG8_SA(1, 0), cA + kstep, voffA); PG8_STAGE(PG8_SB(1, 1), cB + hstep + kstep, voffB);
        PG8_WAIT_V(6); PG8_BAR;
    } else {
        PG8_STAGE(PG8_SB(0, 0), cB, voffB); PG8_STAGE(PG8_SA(0, 0), cA, voffA); PG8_STAGE(PG8_SB(0, 1), cB + hstep, voffB); PG8_STAGE(PG8_SA(0, 1), cA + hstep, voffA);
        if (wr == 1) PG8_BAR;
        PG8_WAIT_V(4); PG8_BAR;
        PG8_STAGE(PG8_SB(1, 0), cB + kstep, voffB); PG8_STAGE(PG8_SA(1, 0), cA + kstep, voffA); PG8_STAGE(PG8_SB(1, 1), cB + hstep + kstep, voffB);
        PG8_WAIT_V(6); PG8_BAR;
    }
    for (;;) {
        const bool has_next = S.next(ui + 1, nxt);
        const char* nA = has_next ? (const char*)g.A + (size_t)nxt.pm * tstep : cA; const char* nB = has_next ? (const char*)g.Bt + (size_t)nxt.pn * tstep : cB;
        for (int t = 0; t < nt; t += 2) {
            const bool last = (t == nt - 2);
            const char* a1 = cA + (size_t)(t + 1) * kstep;
            const char* a2 = last ? nA : cA + (size_t)(t + 2) * kstep; const char* b2 = last ? nB : cB + (size_t)(t + 2) * kstep;
            const char* a3 = a2 + kstep; const char* b3 = b2 + kstep;
            if (last && has_next) S.a_ready(nxt);
            if constexpr (SP2) {
            PG8_LDB(B0, 0, 0); PG8_LDB(B1, 0, 1); PG8_SCHED; PG8_LDA(At, 0, 0); PG8_STAGE(PG8_SA(1, 1), a1 + hstep, voffA);
            PG8_WAIT_V(8); PG8_WAIT_L(0); PG8_BAR; PG8_MMA(0, 0, At, B0); PG8_MMA(0, 1, At, B1); PG8_BAR; PG8_SCHED;
            PG8_LDA(At, 0, 1); PG8_STAGE(PG8_SB(0, 0), b2, voffB); PG8_STAGE(PG8_SB(0, 1), b2 + hstep, voffB); PG8_STAGE(PG8_SA(0, 0), a2, voffA);
            PG8_WAIT_V(8); PG8_WAIT_L(0); PG8_BAR; PG8_MMA(1, 0, At, B0); PG8_MMA(1, 1, At, B1); PG8_BAR; PG8_SCHED;
            PG8_LDB(B0, 1, 0); PG8_LDB(B1, 1, 1); PG8_SCHED; PG8_LDA(At, 1, 0); PG8_STAGE(PG8_SA(0, 1), a2 + hstep, voffA);
            PG8_WAIT_V(8); PG8_WAIT_L(0); PG8_BAR; PG8_MMA(0, 0, At, B0); PG8_MMA(0, 1, At, B1); PG8_BAR; PG8_SCHED;
            PG8_LDA(At, 1, 1); PG8_STAGE(PG8_SB(1, 0), b3, voffB); PG8_STAGE(PG8_SB(1, 1), b3 + hstep, voffB); PG8_STAGE(PG8_SA(1, 0), a3, voffA);
            PG8_WAIT_V(8); PG8_WAIT_L(0); PG8_BAR; PG8_MMA(1, 0, At, B0); PG8_MMA(1, 1, At, B1); PG8_BAR; PG8_SCHED;
            } else {
            PG8_LDB(B0, 0, 0); PG8_SCHED; PG8_LDA(At, 0, 0); PG8_STAGE(PG8_SA(1, 1), a1 + hstep, voffA);
            PG8_WAIT_L(8); PG8_BAR; PG8_WAIT_L(0); PG8_MMA(0, 0, At, B0); PG8_BAR; PG8_SCHED;
            PG8_LDB(B1, 0, 1); PG8_STAGE(PG8_SB(0, 0), b2, voffB);
            PG8_BAR; PG8_WAIT_L(0); PG8_MMA(0, 1, At, B1); PG8_BAR;
            PG8_LDA(At, 0, 1); PG8_STAGE(PG8_SA(0, 0), a2, voffA);
            PG8_BAR; PG8_WAIT_L(0); PG8_MMA(1, 0, At, B0); PG8_BAR; PG8_SCHED;
            PG8_STAGE(PG8_SB(0, 1), b2 + hstep, voffB);
            PG8_WAIT_V(6); PG8_BAR; PG8_MMA(1, 1, At, B1); PG8_BAR;
            PG8_LDB(B0, 1, 0); PG8_SCHED; PG8_LDA(At, 1, 0); PG8_STAGE(PG8_SA(0, 1), a2 + hstep, voffA);
            PG8_WAIT_L(8); PG8_BAR; PG8_WAIT_L(0); PG8_MMA(0, 0, At, B0); PG8_BAR; PG8_SCHED;
            PG8_LDB(B1, 1, 1); PG8_STAGE(PG8_SB(1, 0), b3, voffB);
            PG8_BAR; PG8_WAIT_L(0); PG8_MMA(0, 1, At, B1); PG8_BAR;
            PG8_LDA(At, 1, 1); PG8_STAGE(PG8_SA(1, 0), a3, voffA);
            PG8_BAR; PG8_WAIT_L(0); PG8_MMA(1, 0, At, B0); PG8_BAR; PG8_SCHED;
            PG8_STAGE(PG8_SB(1, 1), b3 + hstep, voffB);
            PG8_WAIT_V(6); PG8_BAR; PG8_MMA(1, 1, At, B1); PG8_BAR;
            }
        }
        if constexpr (ALIGN_EPI) { if (wr == 0) PG8_BAR; }
        if constexpr (!Epi::AFTER_DRAIN) { E(acc, cur, wr, wc, fr, fq); S.done(cur); }
        if (!has_next) break;
#pragma unroll
        for (int a = 0; a < 2; ++a)
#pragma unroll
            for (int b = 0; b < 2; ++b)
#pragma unroll
                for (int m = 0; m < 4; ++m)
#pragma unroll
                    for (int n = 0; n < 2; ++n) acc[a][b][m][n] = (f32x4){0.f, 0.f, 0.f, 0.f};
        cur = nxt; cA = nA; cB = nB; ++ui;
        if constexpr (ALIGN_EPI) { if (wr == 1) PG8_BAR; }
    }
    PG8_WAIT_V(0);
    if constexpr (!ALIGN_EPI) { if (wr == 0) PG8_BAR; }
    PG8_BAR;
    if constexpr (Epi::AFTER_DRAIN) { E.fused(acc, cur, wr, wc, fr, fq, lds, wid, lane); }
#undef PG8_SA
#undef PG8_SB
#undef PG8_STAGE
#undef PG8_LDA
#undef PG8_LDB
#undef PG8_MMA
#undef PG8_WAIT_V
#undef PG8_WAIT_L
#undef PG8_BAR
#undef PG8_SCHED
}
}

typedef unsigned short bf16_t;
typedef short bf16x8 __attribute__((ext_vector_type(8)));
typedef float f32x4 __attribute__((ext_vector_type(4)));
typedef float f32x16 __attribute__((ext_vector_type(16)));
typedef unsigned u32x4 __attribute__((ext_vector_type(4)));
typedef unsigned u32x2 __attribute__((ext_vector_type(2)));
#define LAS __attribute__((address_space(3)))

constexpr int SEQ = 16384, DM = 1024, DIN = 6168, NMAIN = 6144;
constexpr float EPS = 1e-6f;
constexpr size_t MiB = 1u << 20;
constexpr size_t WS_CT = 0;
constexpr size_t WS_GL = 64 * 1024;
constexpr size_t WS_BAR = 128 * 1024;
constexpr size_t WS_PCNT = 144 * 1024;
constexpr size_t WS_XB = 256 * 1024;
constexpr size_t WS_SMALL = 1 * MiB;
constexpr size_t WS_CL = 3 * MiB;
constexpr size_t WS_WSM = 4 * MiB;
constexpr size_t WS_WUPA = 5 * MiB, WS_WUPB = 6 * MiB, WS_WOUT = 7 * MiB, WS_WIN = 9 * MiB;
constexpr size_t WS_H = 21 * MiB;
constexpr size_t WS_WB = WS_H, WS_VT = WS_H + 16 * MiB;
constexpr size_t WS_PROJ = 53 * MiB;
constexpr size_t BUF_ELEMS = (size_t)SEQ * 512;
constexpr size_t WS_PG = 246 * MiB;
constexpr size_t WS_QG = 248 * MiB;
constexpr size_t WS_END = 252 * MiB;
constexpr int LDS_BYTES = 151552;

struct Params { const float* in[16]; float* out; unsigned char* ws; };

DI float bflo(unsigned u) { return __uint_as_float(u << 16); }
DI float bfhi(unsigned u) { return __uint_as_float(u & 0xffff0000u); }
DI float bf2f(bf16_t v) { return __uint_as_float(((unsigned)v) << 16); }
typedef float f32x2_t __attribute__((ext_vector_type(2))); typedef __bf16 bf16x2_t __attribute__((ext_vector_type(2)));
DI unsigned pk2(float lo, float hi) { f32x2_t v = {lo, hi}; bf16x2_t b = __builtin_convertvector(v, bf16x2_t); return __builtin_bit_cast(unsigned, b); }
DI float wave_sum(float v) {
#pragma unroll
    for (int o = 1; o < 64; o <<= 1) v += __shfl_xor(v, o);
    return v;
}
DI float wave_max(float v) {
#pragma unroll
    for (int o = 1; o < 64; o <<= 1) v = fmaxf(v, __shfl_xor(v, o));
    return v;
}
DI float dpp_xor1(float v) { return __int_as_float(__builtin_amdgcn_update_dpp(0, __float_as_int(v), 0xB1, 0xf, 0xf, false)); }
DI float dpp_xor2(float v) { return __int_as_float(__builtin_amdgcn_update_dpp(0, __float_as_int(v), 0x4E, 0xf, 0xf, false)); }
DI float dpp_half_mirror(float v) { return __int_as_float(__builtin_amdgcn_update_dpp(0, __float_as_int(v), 0x141, 0xf, 0xf, false)); }
DI float wave_incl_scan(float v) {
#define SCAN_DPP(ctrl, rmask) v += __int_as_float(__builtin_amdgcn_update_dpp(0, __float_as_int(v), ctrl, rmask, 0xf, false))
    SCAN_DPP(0x111, 0xf); SCAN_DPP(0x112, 0xf); SCAN_DPP(0x114, 0xf); SCAN_DPP(0x118, 0xf); SCAN_DPP(0x142, 0xa); SCAN_DPP(0x143, 0xc);
#undef SCAN_DPP
    return v;
}
DI float sigmf(float v) { return __builtin_amdgcn_rcpf(1.0f + __expf(-v)); }
DI float softplusf(float v) { return v > 20.f ? v : __logf(1.0f + __expf(v)); }
#define MFMA16(a, b, c) __builtin_amdgcn_mfma_f32_16x16x32_bf16((a), (b), (c), 0, 0, 0)
#define MFMA32(a, b, c) __builtin_amdgcn_mfma_f32_32x32x16_bf16((a), (b), (c), 0, 0, 0)
#define LDSFENCE() asm volatile("s_waitcnt lgkmcnt(0)" ::: "memory")

DI void p0_transpose_item(const float* W, int ldN, int srccol, bf16_t* WT, int K, int destrow, int k0, float* scr, int lane) {
    float tv[32];
#pragma unroll
    for (int i = 0; i < 32; ++i) { const int kk = 2 * i + (lane >> 5); tv[i] = __builtin_nontemporal_load(&W[(size_t)(k0 + kk) * ldN + srccol + (lane & 31)]); }
#pragma unroll
    for (int i = 0; i < 32; ++i) { const int kk = 2 * i + (lane >> 5); scr[kk * 33 + (lane & 31)] = tv[i]; }
    LDSFENCE();
    const int c = lane & 7;
#pragma unroll
    for (int j = 0; j < 4; ++j) { const int n = (lane >> 3) + 8 * j; const float* s = scr + (8 * c) * 33 + n;
        u32x4 o; o.x = pk2(s[0 * 33], s[1 * 33]); o.y = pk2(s[2 * 33], s[3 * 33]); o.z = pk2(s[4 * 33], s[5 * 33]); o.w = pk2(s[6 * 33], s[7 * 33]);
        *(u32x4*)(WT + (size_t)(destrow + n) * K + k0 + 8 * c) = o; }
    LDSFENCE();
}

DI void phase0(const Params& P, unsigned char* lds, int tid, int G) {
    const int lane = tid & 63, wave = tid >> 6;
    unsigned char* ws = P.ws;
    float* scr = (float*)(lds + wave * 16384);
    const int gw = blockIdx.x * 8 + wave, NGW = G * 8;
    const float* Win = P.in[2];
    constexpr int I_IN = 16 * 192, I_UP = 8 * 32, I_OUT = 16 * 32;
    for (int it = gw; it < I_IN + 2 * I_UP + I_OUT; it += NGW) {
        int r = it;
        if (r < I_IN) { const int kb = r / 192, nb = r % 192, n0 = 32 * nb; const int src = n0 < 2048 ? n0 : (n0 < 4096 ? n0 + 16 : n0 + 24);
            p0_transpose_item(Win, DIN, src, (bf16_t*)(ws + WS_WIN), 1024, n0, 64 * kb, scr, lane); continue; }
        r -= I_IN;
        if (r < I_UP) { p0_transpose_item(P.in[12], 1024, 32 * (r % 32), (bf16_t*)(ws + WS_WUPA), 512, 32 * (r % 32), 64 * (r / 32), scr, lane); continue; }
        r -= I_UP;
        if (r < I_UP) { p0_transpose_item(P.in[13], 1024, 32 * (r % 32), (bf16_t*)(ws + WS_WUPB), 512, 32 * (r % 32), 64 * (r / 32), scr, lane); continue; }
        r -= I_UP;
        p0_transpose_item(P.in[14], 1024, 32 * (r % 32), (bf16_t*)(ws + WS_WOUT), 1024, 32 * (r % 32), 64 * (r / 32), scr, lane);
    }
    { bf16_t* wsm = (bf16_t*)(ws + WS_WSM);
      for (int idx = blockIdx.x * 512 + tid; idx < 32 * 1024; idx += G * 512) { const int n = idx >> 10, k = idx & 1023;
          float v = 0.f; if (n < 16) v = Win[(size_t)k * DIN + 2048 + n]; else if (n < 24) v = Win[(size_t)k * DIN + 4112 + (n - 16)];
          wsm[idx] = (bf16_t)(pk2(v, 0.f) & 0xffffu); } }
    { const float* x = P.in[0]; const float* nw = P.in[1]; bf16_t* H = (bf16_t*)(ws + WS_H);
      f32x4 wv[4];
#pragma unroll
      for (int j = 0; j < 4; ++j) wv[j] = *(const f32x4*)(nw + 4 * lane + 256 * j);
      for (int m0 = gw; m0 < SEQ; m0 += 4 * NGW) {
          f32x4 v[4][4];
#pragma unroll
          for (int q = 0; q < 4; ++q) { const int m = m0 + q * NGW < SEQ ? m0 + q * NGW : m0; const f32x4* xr = (const f32x4*)(x + (size_t)m * DM) + lane;
#pragma unroll
              for (int j = 0; j < 4; ++j) v[q][j] = __builtin_nontemporal_load(xr + 64 * j); }
#pragma unroll
          for (int q = 0; q < 4; ++q) { const int m = m0 + q * NGW; if (m < SEQ) { float s = 0.f;
#pragma unroll
              for (int j = 0; j < 4; ++j) s += (v[q][j].x * v[q][j].x + v[q][j].y * v[q][j].y) + (v[q][j].z * v[q][j].z + v[q][j].w * v[q][j].w);
              const float rstd = rsqrtf(wave_sum(s) * (1.f / DM) + EPS);
              u32x2* o8 = (u32x2*)(H + (size_t)m * DM) + lane;
#pragma unroll
              for (int j = 0; j < 4; ++j) { u32x2 o; o.x = pk2(v[q][j].x * rstd * wv[j].x, v[q][j].y * rstd * wv[j].y); o.y = pk2(v[q][j].z * rstd * wv[j].z, v[q][j].w * rstd * wv[j].w); o8[64 * j] = o; } } }
      } }
}

DI void small_proj(const Params& P, unsigned char* lds, int tid, int G) {
    const int lane = tid & 63, wave = tid >> 6;
    const bf16_t* H = (const bf16_t*)(P.ws + WS_H); const bf16_t* W = (const bf16_t*)(P.ws + WS_WSM); float* SM = (float*)(P.ws + WS_SMALL);
    const int r32 = lane & 31, hi = lane >> 5, ru = wave >> 2, kq = wave & 3;
    float* part = (float*)lds;
    for (int u2 = blockIdx.x; u2 < SEQ / 64; u2 += G) {
        const int u = 2 * u2 + ru;
        f32x16 acc; for (int i = 0; i < 16; ++i) acc[i] = 0.f;
        const bf16_t* ap = H + (size_t)(u * 32 + r32) * DM + 256 * kq + 8 * hi; const bf16_t* bp = W + (size_t)r32 * DM + 256 * kq + 8 * hi;
        bf16x8 a[16], b[16];
#pragma unroll
        for (int ks = 0; ks < 16; ++ks) { a[ks] = *(const bf16x8*)(ap + 16 * ks); b[ks] = *(const bf16x8*)(bp + 16 * ks); }
#pragma unroll
        for (int ks = 0; ks < 16; ++ks) acc = MFMA32(a[ks], b[ks], acc);
#pragma unroll
        for (int r = 0; r < 16; ++r) part[(wave * 16 + r) * 64 + lane] = acc[r];
        __syncthreads();
#pragma unroll
        for (int k = 0; k < 4; ++k) { const int o = tid + 512 * k, uu = o >> 10, r = (o >> 6) & 15, l = o & 63;
            const float v = part[((uu * 4 + 0) * 16 + r) * 64 + l] + part[((uu * 4 + 1) * 16 + r) * 64 + l] + part[((uu * 4 + 2) * 16 + r) * 64 + l] + part[((uu * 4 + 3) * 16 + r) * 64 + l];
            const int row = (r & 3) + 8 * (r >> 2) + 4 * (l >> 5);
            SM[(size_t)((2 * u2 + uu) * 32 + row) * 32 + (l & 31)] = v; }
        __syncthreads();
    }
}

DI int permpos(int a) { return 32 * (a >> 5) + 8 * ((a >> 2) & 3) + 4 * ((a >> 4) & 1) + (a & 3); }
#define PREP_BAR() do { asm volatile("s_waitcnt lgkmcnt(0)\n\ts_barrier" ::: "memory"); } while (0)
DI void gdn_load(const Params& P, int u, int tid, u32x4 (&raw)[12], float& sb, float& sa) {
    const int h = u & 7, n = u >> 3, t = tid >> 3, c8 = tid & 7, tok = n * 64 + t;
    const bf16_t* PROJ = (const bf16_t*)(P.ws + WS_PROJ); const float* SM = (const float*)(P.ws + WS_SMALL);
#pragma unroll
    for (int xx = 0; xx < 3; ++xx)
#pragma unroll
        for (int j = 0; j < 4; ++j) { const int tk = tok - 3 + j; u32x4 v = {0u, 0u, 0u, 0u};
            if (tk >= 0) v = *(const u32x4*)(PROJ + (size_t)xx * BUF_ELEMS + h * 64 + 8 * c8 + (size_t)tk * 512);
            raw[xx * 4 + j] = v; }
    sb = SM[(size_t)tok * 32 + h]; sa = SM[(size_t)tok * 32 + 8 + h];
}
DI void gdn_prep_unit(const Params& P, int h, int n, unsigned char* lds, int tid, u32x4 (&raw)[12], float& sbv, float& sav, int unext, bool cw_lds = false) {
    unsigned char* ws = P.ws;
    bf16_t* Kimg = (bf16_t*)(lds); bf16_t* Qimg = (bf16_t*)(lds + 9216);
    float* Ml = (float*)(lds + 18432); float* X = (float*)(lds + 35840);
    float* graw = (float*)(lds + 69632); float* gcs = graw + 64; float* bet = graw + 128;
    bf16_t* Aimg = (bf16_t*)(lds + 76800);
    const bf16_t* PROJ = (const bf16_t*)(ws + WS_PROJ); const float* SM = (const float*)(ws + WS_SMALL);
    const float* convw = P.in[4];
    const int unit = h * 256 + n;
    bf16_t* IMG = (bf16_t*)P.out + (size_t)unit * 16384;
    const int lane = tid & 63, wave = tid >> 6;
    const int t = tid >> 3, c8 = tid & 7, tok = n * 64 + t;
    float y[3][8];
#pragma unroll
    for (int xx = 0; xx < 3; ++xx) {
        float acc[8];
#pragma unroll
        for (int e = 0; e < 8; ++e) acc[e] = 0.f;
#pragma unroll
        for (int j = 0; j < 4; ++j) { const u32x4 rw = raw[xx * 4 + j];
            const float* wp = cw_lds ? (const float*)(lds + 86016) + (j * 3 + xx) * 64 + 8 * c8 : convw + j * 1536 + xx * 512 + h * 64 + 8 * c8;
            const f32x4 w0 = *(const f32x4*)wp, w1 = *(const f32x4*)(wp + 4);
            acc[0] += w0.x * bflo(rw.x); acc[1] += w0.y * bfhi(rw.x); acc[2] += w0.z * bflo(rw.y); acc[3] += w0.w * bfhi(rw.y);
            acc[4] += w1.x * bflo(rw.z); acc[5] += w1.y * bfhi(rw.z); acc[6] += w1.z * bflo(rw.w); acc[7] += w1.w * bfhi(rw.w); }
#pragma unroll
        for (int e = 0; e < 8; ++e) y[xx][e] = acc[e] * sigmf(acc[e]);
    }
    const float sb_c = sbv, sa_c = sav;
    float ssq = 0.f, ssk = 0.f;
#pragma unroll
    for (int e = 0; e < 8; ++e) { ssq += y[0][e] * y[0][e]; ssk += y[1][e] * y[1][e]; }
    ssq += dpp_xor1(ssq); ssq += dpp_xor2(ssq); ssq += dpp_half_mirror(ssq);
    ssk += dpp_xor1(ssk); ssk += dpp_xor2(ssk); ssk += dpp_half_mirror(ssk);
    const float rq = rsqrtf(ssq + EPS) * 0.125f, rk = rsqrtf(ssk + EPS);
    const float beta = sigmf(sb_c);
    const float gt = -__expf(P.in[5][h]) * softplusf(sa_c + P.in[6][h]);
    graw[t] = gt; bet[t] = beta;
    PREP_BAR();
    if (wave == 0) gcs[lane] = wave_incl_scan(graw[lane]);
    PREP_BAR();
    const float gc = gcs[t];
    const float eg = __expf(gc);
    { u32x4 kk, qq; float q[8], k[8];
#pragma unroll
      for (int e = 0; e < 8; ++e) { q[e] = y[0][e] * rq; k[e] = y[1][e] * rk; }
      kk.x = pk2(k[0], k[1]); kk.y = pk2(k[2], k[3]); kk.z = pk2(k[4], k[5]); kk.w = pk2(k[6], k[7]);
      qq.x = pk2(q[0], q[1]); qq.y = pk2(q[2], q[3]); qq.z = pk2(q[4], q[5]); qq.w = pk2(q[6], q[7]);
      *(u32x4*)(Kimg + t * 72 + 8 * c8) = kk; *(u32x4*)(Qimg + t * 72 + 8 * c8) = qq;
#pragma unroll
      for (int e = 0; e < 8; e += 4) { const float kb = beta * eg;
          *(f32x4*)(X + t * 132 + 8 * c8 + e) = (f32x4){y[2][e] * beta, y[2][e + 1] * beta, y[2][e + 2] * beta, y[2][e + 3] * beta};
          *(f32x4*)(X + t * 132 + 64 + 8 * c8 + e) = (f32x4){k[e] * kb, k[e + 1] * kb, k[e + 2] * kb, k[e + 3] * kb}; }
      const int p0 = 32 * (c8 >> 2) + 16 * (c8 & 1) + 4 * ((c8 >> 1) & 1);
      u32x2 a, b; a.x = pk2(q[0] * eg, q[1] * eg); a.y = pk2(q[2] * eg, q[3] * eg); b.x = pk2(q[4] * eg, q[5] * eg); b.y = pk2(q[6] * eg, q[7] * eg);
      const int swt = (t >> 1) & 7, ch0 = p0 >> 3, wi = p0 & 7;
      *(u32x2*)(IMG + 4096 + t * 64 + ((ch0 ^ swt) << 3) + wi) = a; *(u32x2*)(IMG + 4096 + t * 64 + (((ch0 + 1) ^ swt) << 3) + wi) = b; }
    PREP_BAR();
    { const int l15 = lane & 15, g = lane >> 4;
#pragma unroll
      for (int bb = 0; bb < 2; ++bb) { const int blk = 2 * wave + bb, bi = blk >> 2, bj = blk & 3;
          f32x4 aq = {0.f, 0.f, 0.f, 0.f}, ak = {0.f, 0.f, 0.f, 0.f};
#pragma unroll
          for (int s = 0; s < 2; ++s) {
              const bf16x8 bk = *(const bf16x8*)(Kimg + (16 * bj + l15) * 72 + 32 * s + 8 * g);
              const bf16x8 aqf = *(const bf16x8*)(Qimg + (16 * bi + l15) * 72 + 32 * s + 8 * g);
              aq = MFMA16(aqf, bk, aq);
              if (bj <= bi) { const bf16x8 akf = *(const bf16x8*)(Kimg + (16 * bi + l15) * 72 + 32 * s + 8 * g); ak = MFMA16(akf, bk, ak); }
          }
          const int j = 16 * bj + l15; const float gj = gcs[j]; const int pj = permpos(j);
#pragma unroll
          for (int r = 0; r < 4; ++r) { const int i = 16 * bi + 4 * g + r; const float dec = (j <= i) ? __expf(gcs[i] - gj) : 0.f;
              Aimg[i * 64 + ((((pj >> 3) ^ (i >> 1)) & 7) << 3) + (pj & 7)] = (bf16_t)(pk2(aq[r] * dec, 0.f) & 0xffffu);
              if (bj <= bi) Ml[i * 68 + j] = (j < i) ? bet[i] * ak[r] * dec : 0.f; }
      } }
    PREP_BAR();
    if (unext >= 0) gdn_load(P, unext, tid, raw, sbv, sav);
    float* Tl = (float*)(lds + 70400);
    if (wave < 4) { const int b = wave, col = lane >> 2, q4 = lane & 3;
      float xr[4] = {0.f, 0.f, 0.f, 0.f};
#pragma unroll
      for (int p = 0; p < 8; ++p) { const int i0 = 2 * p, i1 = 2 * p + 1;
          const float* d0 = Ml + (16 * b + i0) * 68 + 16 * b; const float* d1 = Ml + (16 * b + i1) * 68 + 16 * b;
          float p0 = 0.f, p1 = 0.f;
#pragma unroll
          for (int m = 0; m < (i1 + 3) / 4; ++m) { p0 += d0[4 * m + q4] * xr[m]; p1 += d1[4 * m + q4] * xr[m]; }
          p0 += dpp_xor1(p0); p1 += dpp_xor1(p1); p0 += dpp_xor2(p0); p1 += dpp_xor2(p1);
          const float x0 = (i0 == col ? 1.f : 0.f) - p0;
          const float x1 = (i1 == col ? 1.f : 0.f) - p1 - d1[i0] * x0;
          if (q4 == (i0 & 3)) xr[i0 >> 2] = x0;
          if (q4 == (i1 & 3)) xr[i1 >> 2] = x1;
          Tl[(16 * b + i0) * 20 + col] = x0; Tl[(16 * b + i1) * 20 + col] = x1;
      } }
    else {
      const float glast = gcs[63];
#pragma unroll
      for (int k2 = 0; k2 < 2; ++k2) { const int it_ = (tid - 256) + 256 * k2, c = it_ >> 3, pg = it_ & 7, s = pg >> 2, g = pg & 3;
          float w[8];
#pragma unroll
          for (int j = 0; j < 8; ++j) { const int d = 32 * s + 16 * (j >> 2) + 4 * g + (j & 3); w[j] = bf2f(Kimg[d * 72 + c]) * __expf(glast - gcs[d]); }
          u32x4 o2; o2.x = pk2(w[0], w[1]); o2.y = pk2(w[2], w[3]); o2.z = pk2(w[4], w[5]); o2.w = pk2(w[6], w[7]);
          *(u32x4*)(IMG + 12288 + c * 64 + 8 * ((pg ^ (c >> 1)) & 7)) = o2;
          *(u32x4*)(IMG + 8192 + it_ * 8) = *(const u32x4*)(Aimg + it_ * 8); }
      if (tid == 256) ((float*)(ws + WS_GL))[unit] = __expf(glast); }
    PREP_BAR();
    { const int l15 = lane & 15, g = lane >> 4;
      u32x2 xh[4];
#pragma unroll
      for (int b = 0; b < 4; ++b) {
          float* xp = X + (16 * b + 4 * g) * 132 + 16 * wave + l15;
          f32x4 acc = {xp[0], xp[132], xp[264], xp[396]};
#pragma unroll
          for (int bp = 0; bp < b; bp += 2) {
              const f32x4 a0 = *(const f32x4*)(Ml + (16 * b + l15) * 68 + 16 * bp + 4 * g);
              f32x4 a1 = {0.f, 0.f, 0.f, 0.f}; u32x2 x1 = {0u, 0u};
              if (bp + 1 < b) { a1 = *(const f32x4*)(Ml + (16 * b + l15) * 68 + 16 * (bp + 1) + 4 * g); x1 = xh[bp + 1]; }
              u32x4 ap; ap.x = pk2(-a0[0], -a0[1]); ap.y = pk2(-a0[2], -a0[3]); ap.z = pk2(-a1[0], -a1[1]); ap.w = pk2(-a1[2], -a1[3]);
              u32x4 bpk; bpk.x = xh[bp].x; bpk.y = xh[bp].y; bpk.z = x1.x; bpk.w = x1.y;
              acc = MFMA16(__builtin_bit_cast(bf16x8, ap), __builtin_bit_cast(bf16x8, bpk), acc); }
          const f32x4 tt = *(const f32x4*)(Tl + (16 * b + l15) * 20 + 4 * g);
          f32x4 xb = {0.f, 0.f, 0.f, 0.f};
          { u32x4 tp; tp.x = pk2(tt[0], tt[1]); tp.y = pk2(tt[2], tt[3]); tp.z = 0u; tp.w = 0u;
            u32x4 rp; rp.x = pk2(acc[0], acc[1]); rp.y = pk2(acc[2], acc[3]); rp.z = 0u; rp.w = 0u;
            xb = MFMA16(__builtin_bit_cast(bf16x8, tp), __builtin_bit_cast(bf16x8, rp), xb); }
          xh[b].x = pk2(xb[0], xb[1]); xh[b].y = pk2(xb[2], xb[3]);
          xp[0] = xb[0]; xp[132] = xb[1]; xp[264] = xb[2]; xp[396] = xb[3];
      } }
    PREP_BAR();
    { bf16_t* WB = (bf16_t*)(ws + WS_WB) + (size_t)unit * 4096;
#pragma unroll
      for (int k = 0; k < 2; ++k) { const int gidx = tid + 512 * k, cgi = gidx >> 8, mb = (gidx >> 6) & 3, l = gidx & 63;
          const float* xp = X + (16 * mb + 4 * (l >> 4)) * 132 + 16 * cgi + (l & 15);
          u32x2 o; o.x = pk2(xp[0], xp[132]); o.y = pk2(xp[264], xp[396]); *(u32x2*)(WB + gidx * 4) = o; }
      const int c = tid >> 3, pg = tid & 7, s = pg >> 2, g = pg & 3;
      float v[8];
#pragma unroll
      for (int j = 0; j < 8; ++j) { const int d = 32 * s + 16 * (j >> 2) + 4 * g + (j & 3); v[j] = -X[c * 132 + 64 + d]; }
      u32x4 o1; o1.x = pk2(v[0], v[1]); o1.y = pk2(v[2], v[3]); o1.z = pk2(v[4], v[5]); o1.w = pk2(v[6], v[7]);
      *(u32x4*)(IMG + c * 64 + 8 * ((pg ^ (c >> 1)) & 7)) = o1; }
}

DI void fox_prep_unit(const Params& P, int n, unsigned char* lds, int tid) {
    unsigned char* ws = P.ws;
    const int h = tid >> 6, t = tid & 63, tok = n * 64 + t;
    bf16_t* FQ = (bf16_t*)(ws + WS_PROJ) + 4 * BUF_ELEMS + (size_t)tok * 512 + h * 64;
    bf16_t* FK = (bf16_t*)(ws + WS_PROJ) + 5 * BUF_ELEMS + (size_t)tok * 512 + h * 64;
    const bf16_t* FV = (const bf16_t*)(ws + WS_PROJ) + 6 * BUF_ELEMS + (size_t)tok * 512 + h * 64;
#pragma unroll
    for (int which = 0; which < 2; ++which) {
        bf16_t* ptr = which ? FK : FQ; const float* nw = which ? P.in[10] : P.in[9]; const float sc = which ? 1.0f : 0.125f * 1.4426950408889634f;
        u32x4 raw[8]; float ss = 0.f;
#pragma unroll
        for (int i = 0; i < 8; ++i) { raw[i] = *(const u32x4*)(ptr + 8 * i);
            const float a0 = bflo(raw[i].x), a1 = bfhi(raw[i].x), a2 = bflo(raw[i].y), a3 = bfhi(raw[i].y), a4 = bflo(raw[i].z), a5 = bfhi(raw[i].z), a6 = bflo(raw[i].w), a7 = bfhi(raw[i].w);
            ss += (a0 * a0 + a1 * a1) + (a2 * a2 + a3 * a3) + (a4 * a4 + a5 * a5) + (a6 * a6 + a7 * a7); }
        const float rstd = rsqrtf(ss * (1.f / 64.f) + EPS) * sc;
#pragma unroll
        for (int i = 0; i < 8; ++i) { const f32x4 w0 = *(const f32x4*)(nw + 8 * i), w1 = *(const f32x4*)(nw + 8 * i + 4); u32x4 o;
            o.x = pk2(bflo(raw[i].x) * rstd * w0.x, bfhi(raw[i].x) * rstd * w0.y); o.y = pk2(bflo(raw[i].y) * rstd * w0.z, bfhi(raw[i].y) * rstd * w0.w);
            o.z = pk2(bflo(raw[i].z) * rstd * w1.x, bfhi(raw[i].z) * rstd * w1.y); o.w = pk2(bflo(raw[i].w) * rstd * w1.z, bfhi(raw[i].w) * rstd * w1.w);
            *(u32x4*)(ptr + 8 * i) = o; }
    }
    { bf16_t* tile = (bf16_t*)(lds + h * 9216);
#pragma unroll
      for (int i = 0; i < 8; ++i) { const u32x4 r = *(const u32x4*)(FV + 8 * i);
          tile[(8 * i + 0) * 72 + t] = (bf16_t)(r.x & 0xffffu); tile[(8 * i + 1) * 72 + t] = (bf16_t)(r.x >> 16);
          tile[(8 * i + 2) * 72 + t] = (bf16_t)(r.y & 0xffffu); tile[(8 * i + 3) * 72 + t] = (bf16_t)(r.y >> 16);
          tile[(8 * i + 4) * 72 + t] = (bf16_t)(r.z & 0xffffu); tile[(8 * i + 5) * 72 + t] = (bf16_t)(r.z >> 16);
          tile[(8 * i + 6) * 72 + t] = (bf16_t)(r.w & 0xffffu); tile[(8 * i + 7) * 72 + t] = (bf16_t)(r.w >> 16); }
      LDSFENCE();
      bf16_t* VT = (bf16_t*)(ws + WS_VT) + (size_t)(h * 64) * SEQ + (size_t)n * 64;
#pragma unroll
      for (int k = 0; k < 8; ++k) { const int idx = t + 64 * k, d = idx >> 3, c = idx & 7;
          *(u32x4*)(VT + (size_t)d * SEQ + 8 * c) = *(const u32x4*)(tile + d * 72 + 8 * c); }
      LDSFENCE(); }
    { const float f = ((const float*)(ws + WS_SMALL))[(size_t)tok * 32 + 16 + h] + P.in[8][h];
      float v = -softplusf(-f) * 1.4426950408889634f;
      v = wave_incl_scan(v);
      ((float*)(ws + WS_CL))[(size_t)h * SEQ + tok] = v;
      if (t == 63) ((float*)(ws + WS_CT))[h * 256 + n] = v; }
}

constexpr int SCAN_L = 8, SCAN_G = 256 / SCAN_L;
#define SCAN_BAR() do { __builtin_amdgcn_sched_barrier(0); asm volatile("s_waitcnt lgkmcnt(0)\n\ts_barrier" ::: "memory"); __builtin_amdgcn_sched_barrier(0); } while (0)
#define ORDER_FENCE() do { asm volatile("" ::: "memory"); __builtin_amdgcn_sched_barrier(0); } while (0)
DI bf16x8 pack8(const f32x4& a, const f32x4& b) { u32x4 p; p.x = pk2(a[0], a[1]); p.y = pk2(a[2], a[3]); p.z = pk2(b[0], b[1]); p.w = pk2(b[2], b[3]); return __builtin_bit_cast(bf16x8, p); }
template <bool PASS1>
DI void gdn_scan(const Params& P, int h, int g, unsigned char* lds, LAS unsigned char* ldsl, int tid) {
    unsigned char* ws = P.ws;
    const int lane = tid & 63, wave = __builtin_amdgcn_readfirstlane(tid >> 6);
    const int c0 = g * SCAN_L;
    bf16_t* obuf = (bf16_t*)(lds + 131072);
    float* gll = (float*)(lds + 149504);
    const bf16_t* IMGH = (const bf16_t*)P.out + (size_t)(h * 256 + c0) * 16384;
    const float* GLp = (const float*)(ws + WS_GL) + h * 256 + c0;
    bf16_t* PIMG = (bf16_t*)(ws + WS_PG);
    float* QACC = (float*)(ws + WS_QG);
    if (wave >= 6) {
        if constexpr (PASS1) {
            for (int n = 0; n <= SCAN_L; ++n) SCAN_BAR();
        } else {
        const int ftid = tid - 384, tl = ftid >> 1, e0 = 32 * (ftid & 1);
        float gw[32];
#pragma unroll
        for (int e = 0; e < 32; ++e) gw[e] = P.in[7][e0 + e];
        const bf16_t* GZ = (const bf16_t*)(ws + WS_PROJ) + 3 * BUF_ELEMS + h * 64 + e0 + (size_t)(c0 * 64 + tl) * 512;
        bf16_t* YA = (bf16_t*)(ws + WS_PROJ) + 0 * BUF_ELEMS + h * 64 + e0 + (size_t)(c0 * 64 + tl) * 512;
        u32x4 Z0[4], Z1[4], Z2[4], Z3[4];
#define LDZ(Z, u_) do { const int uu_ = (u_) < SCAN_L ? (u_) : SCAN_L - 1; _Pragma("unroll") for (int i = 0; i < 4; ++i) Z[i] = *(const u32x4*)(GZ + (size_t)uu_ * 32768 + 8 * i); } while (0)
#define FSIG(z) __builtin_amdgcn_rcpf(1.0f + __expf(-(z)))
#define FIN_STEP(Z, nn_) do { const int nn = (nn_); \
            const bf16_t* ob = obuf + (nn & 1) * 4608 + tl * 72 + e0; \
            float of[32]; float ss = 0.f; \
            _Pragma("unroll") for (int i = 0; i < 4; ++i) { const u32x4 ov = *(const u32x4*)(ob + 8 * i); \
                of[8 * i] = bflo(ov.x); of[8 * i + 1] = bfhi(ov.x); of[8 * i + 2] = bflo(ov.y); of[8 * i + 3] = bfhi(ov.y); \
                of[8 * i + 4] = bflo(ov.z); of[8 * i + 5] = bfhi(ov.z); of[8 * i + 6] = bflo(ov.w); of[8 * i + 7] = bfhi(ov.w); } \
            _Pragma("unroll") for (int e = 0; e < 32; ++e) ss += of[e] * of[e]; \
            ss += dpp_xor1(ss); \
            const float rstd = rsqrtf(ss * (1.f / 64.f) + EPS); \
            _Pragma("unroll") for (int i = 0; i < 4; ++i) { \
                const float z0 = bflo(Z[i].x), z1 = bfhi(Z[i].x), z2 = bflo(Z[i].y), z3 = bfhi(Z[i].y), z4 = bflo(Z[i].z), z5 = bfhi(Z[i].z), z6 = bflo(Z[i].w), z7 = bfhi(Z[i].w); \
                u32x4 w; \
                w.x = pk2(of[8 * i] * rstd * gw[8 * i] * z0 * FSIG(z0), of[8 * i + 1] * rstd * gw[8 * i + 1] * z1 * FSIG(z1)); \
                w.y = pk2(of[8 * i + 2] * rstd * gw[8 * i + 2] * z2 * FSIG(z2), of[8 * i + 3] * rstd * gw[8 * i + 3] * z3 * FSIG(z3)); \
                w.z = pk2(of[8 * i + 4] * rstd * gw[8 * i + 4] * z4 * FSIG(z4), of[8 * i + 5] * rstd * gw[8 * i + 5] * z5 * FSIG(z5)); \
                w.w = pk2(of[8 * i + 6] * rstd * gw[8 * i + 6] * z6 * FSIG(z6), of[8 * i + 7] * rstd * gw[8 * i + 7] * z7 * FSIG(z7)); \
                *(u32x4*)(YA + (size_t)nn * 32768 + 8 * i) = w; } \
            LDZ(Z, nn + 4); } while (0)
        LDZ(Z0, 0); ORDER_FENCE(); LDZ(Z1, 1); ORDER_FENCE(); LDZ(Z2, 2); ORDER_FENCE(); LDZ(Z3, 3); ORDER_FENCE();
        if (g > 0) for (int i = 0; i <= g; ++i) SCAN_BAR();
        SCAN_BAR();
        SCAN_BAR();
        for (int nb = 0; nb < SCAN_L; nb += 4) {
            FIN_STEP(Z0, nb); SCAN_BAR(); FIN_STEP(Z1, nb + 1); SCAN_BAR(); FIN_STEP(Z2, nb + 2); SCAN_BAR(); FIN_STEP(Z3, nb + 3); if (nb + 3 < SCAN_L - 1) SCAN_BAR();
        }
#undef FIN_STEP
#undef FSIG
#undef LDZ
        }
    } else if (wave >= 4) {
        const int dw = wave - 4;
        constexpr int NP = PASS1 ? 8 : 16;
        const int piece0 = PASS1 ? 24 * dw : 16 * dw;
#define DMA_UNIT(u, slot) do { const char* src_ = (const char*)(IMGH + (size_t)(u) * 16384) + piece0 * 1024 + lane * 16; \
        _Pragma("unroll") for (int k_ = 0; k_ < NP; ++k_) __builtin_amdgcn_global_load_lds((const unsigned*)(src_ + k_ * 1024), (LAS unsigned*)(ldsl + (slot) * 32768 + (piece0 + k_) * 1024), 16, 0, 0); } while (0)
        if constexpr (!PASS1) { if (g > 0) {
            const char* pq_p = (const char*)(PIMG + (size_t)(h * SCAN_G) * 4096) + dw * 4096 + lane * 16;
            const char* pq_q = (const char*)(QACC + (size_t)(h * SCAN_G) * 4096) + dw * 8192 + lane * 16;
#define DMA_PQ(gi_, slot) do { const int gi = (gi_) < g ? (gi_) : g - 1; \
            _Pragma("unroll") for (int k_ = 0; k_ < 4; ++k_) __builtin_amdgcn_global_load_lds((const unsigned*)(pq_p + (size_t)gi * 8192 + k_ * 1024), (LAS unsigned*)(ldsl + (slot) * 24576 + dw * 4096 + k_ * 1024), 16, 0, 0); \
            _Pragma("unroll") for (int k_ = 0; k_ < 8; ++k_) __builtin_amdgcn_global_load_lds((const unsigned*)(pq_q + (size_t)gi * 16384 + k_ * 1024), (LAS unsigned*)(ldsl + (slot) * 24576 + 8192 + dw * 8192 + k_ * 1024), 16, 0, 0); } while (0)
            DMA_PQ(0, 0); DMA_PQ(1, 1); DMA_PQ(2, 2); DMA_PQ(3, 3);
            asm volatile("s_waitcnt vmcnt(36)" ::: "memory");
            SCAN_BAR();
            for (int gp = 0; gp < g; ++gp) {
                DMA_PQ(gp + 4, (gp + 4) % 5);
                asm volatile("s_waitcnt vmcnt(36)" ::: "memory");
                SCAN_BAR();
            }
            asm volatile("s_waitcnt vmcnt(0)" ::: "memory");
#undef DMA_PQ
        } }
        DMA_UNIT(0, 0); DMA_UNIT(1, 1); DMA_UNIT(2, 2);
        if constexpr (PASS1) asm volatile("s_waitcnt vmcnt(16)" ::: "memory"); else asm volatile("s_waitcnt vmcnt(32)" ::: "memory");
        SCAN_BAR();
        for (int n = 0; n < SCAN_L; ++n) {
            const int un = n + 3 < SCAN_L ? n + 3 : SCAN_L - 1;
            DMA_UNIT(un, (n + 3) & 3);
            if constexpr (PASS1) asm volatile("s_waitcnt vmcnt(16)" ::: "memory"); else asm volatile("s_waitcnt vmcnt(32)" ::: "memory");
            SCAN_BAR();
        }
        asm volatile("s_waitcnt vmcnt(0)" ::: "memory");
#undef DMA_UNIT
    } else {
        const int cgi = wave, l15 = lane & 15, gq = lane >> 4;
        const bf16_t* WBH = (const bf16_t*)(ws + WS_WB) + (size_t)(h * 256 + c0) * 4096 + cgi * 1024 + lane * 4;
        if (tid < SCAN_L) gll[tid] = GLp[tid];
        f32x4 S[4];
#pragma unroll
        for (int mb = 0; mb < 4; ++mb) S[mb] = (f32x4){0.f, 0.f, 0.f, 0.f};
        u32x2 W0[4], W1[4], W2[4], W3[4];
#define LDW(W, u_) do { const int uu_ = (u_) < SCAN_L ? (u_) : SCAN_L - 1; _Pragma("unroll") for (int mb = 0; mb < 4; ++mb) W[mb] = *(const u32x2*)(WBH + (size_t)uu_ * 4096 + mb * 256); } while (0)
        const int aoff0 = l15 * 128 + ((gq ^ (l15 >> 1)) << 4), aoff1 = l15 * 128 + (((4 + gq) ^ (l15 >> 1)) << 4);
#define AFR(mat, mb, s) (*(const bf16x8*)(sb + (mat) * 8192 + (mb) * 2048 + ((s) ? aoff1 : aoff0)))
        if constexpr (PASS1) {
            f32x4 T[4];
#pragma unroll
            for (int mb = 0; mb < 4; ++mb)
#pragma unroll
                for (int r = 0; r < 4; ++r) T[mb][r] = (16 * mb + 4 * gq + r == 16 * cgi + l15) ? 1.f : 0.f;
            LDW(W0, 0); ORDER_FENCE(); LDW(W1, 1); ORDER_FENCE(); LDW(W2, 2); ORDER_FENCE(); LDW(W3, 3); ORDER_FENCE();
            SCAN_BAR();
#define P1_STEP(W, n_) do { const int nq_ = (n_); \
            const unsigned char* sb = lds + (nq_ & 3) * 32768; const float glc = gll[nq_]; \
            bf16x8 Sb[2], Tb[2], Ub[2], Vb[2]; \
            _Pragma("unroll") for (int s = 0; s < 2; ++s) { Sb[s] = pack8(S[2 * s], S[2 * s + 1]); Tb[s] = pack8(T[2 * s], T[2 * s + 1]); } \
            f32x4 u[4], v[4]; \
            _Pragma("unroll") for (int mb = 0; mb < 4; ++mb) { const bf16x8 a0 = AFR(0, mb, 0), a1 = AFR(0, mb, 1); \
                u[mb] = (f32x4){bflo(W[mb].x), bfhi(W[mb].x), bflo(W[mb].y), bfhi(W[mb].y)}; v[mb] = (f32x4){0.f, 0.f, 0.f, 0.f}; \
                u[mb] = MFMA16(a0, Sb[0], u[mb]); v[mb] = MFMA16(a0, Tb[0], v[mb]); u[mb] = MFMA16(a1, Sb[1], u[mb]); v[mb] = MFMA16(a1, Tb[1], v[mb]); } \
            LDW(W, nq_ + 4); \
            _Pragma("unroll") for (int s = 0; s < 2; ++s) { Ub[s] = pack8(u[2 * s], u[2 * s + 1]); Vb[s] = pack8(v[2 * s], v[2 * s + 1]); } \
            _Pragma("unroll") for (int mb = 0; mb < 4; ++mb) { const bf16x8 a0 = AFR(3, mb, 0), a1 = AFR(3, mb, 1); S[mb] = S[mb] * glc; T[mb] = T[mb] * glc; \
                S[mb] = MFMA16(a0, Ub[0], S[mb]); T[mb] = MFMA16(a0, Vb[0], T[mb]); S[mb] = MFMA16(a1, Ub[1], S[mb]); T[mb] = MFMA16(a1, Vb[1], T[mb]); } \
            SCAN_BAR(); } while (0)
            for (int n = 0; n < SCAN_L; n += 4) { P1_STEP(W0, n); P1_STEP(W1, n + 1); P1_STEP(W2, n + 2); P1_STEP(W3, n + 3); }
#undef P1_STEP
            bf16_t* pim = PIMG + (size_t)(h * SCAN_G + g) * 4096; const int pj = permpos(16 * cgi + l15);
            float* qac = QACC + (size_t)(h * SCAN_G + g) * 4096 + cgi * 1024 + lane * 4;
#pragma unroll
            for (int mb = 0; mb < 4; ++mb) {
#pragma unroll
                for (int r = 0; r < 4; ++r) { const int d_ = 16 * mb + 4 * gq + r; pim[d_ * 64 + ((((pj >> 3) ^ (d_ >> 1)) & 7) << 3) + (pj & 7)] = (bf16_t)(pk2(T[mb][r], 0.f) & 0xffffu); }
                *(f32x4*)(qac + mb * 256) = S[mb]; }
        } else {
            LDW(W0, 0); ORDER_FENCE(); LDW(W1, 1); ORDER_FENCE(); LDW(W2, 2); ORDER_FENCE(); LDW(W3, 3); ORDER_FENCE();
            if (g > 0) {
                SCAN_BAR();
                for (int gp = 0; gp < g; ++gp) {
                    const unsigned char* sb = lds + (gp % 5) * 24576;
                    const bf16x8 s0 = pack8(S[0], S[1]), s1 = pack8(S[2], S[3]);
#pragma unroll
                    for (int mb = 0; mb < 4; ++mb) { const f32x4 q = *(const f32x4*)(sb + 8192 + (cgi * 1024 + mb * 256 + lane * 4) * 4);
                        f32x4 a = MFMA16(*(const bf16x8*)(sb + mb * 2048 + aoff0), s0, q); S[mb] = MFMA16(*(const bf16x8*)(sb + mb * 2048 + aoff1), s1, a); }
                    SCAN_BAR();
                }
            }
            SCAN_BAR();
#define SCAN_STEP(W, n_) do { const int nq_ = (n_); \
            const unsigned char* sb = lds + (nq_ & 3) * 32768; const float glc = gll[nq_]; \
            bf16x8 Sb[2], Ub[2]; \
            _Pragma("unroll") for (int s = 0; s < 2; ++s) Sb[s] = pack8(S[2 * s], S[2 * s + 1]); \
            f32x4 u[4], o[4]; \
            _Pragma("unroll") for (int mb = 0; mb < 4; ++mb) { u[mb] = (f32x4){bflo(W[mb].x), bfhi(W[mb].x), bflo(W[mb].y), bfhi(W[mb].y)}; \
                u[mb] = MFMA16(AFR(0, mb, 0), Sb[0], u[mb]); u[mb] = MFMA16(AFR(0, mb, 1), Sb[1], u[mb]); } \
            LDW(W, nq_ + 4); \
            _Pragma("unroll") for (int mb = 0; mb < 4; ++mb) { o[mb] = (f32x4){0.f, 0.f, 0.f, 0.f}; \
                o[mb] = MFMA16(AFR(1, mb, 0), Sb[0], o[mb]); o[mb] = MFMA16(AFR(1, mb, 1), Sb[1], o[mb]); } \
            _Pragma("unroll") for (int s = 0; s < 2; ++s) Ub[s] = pack8(u[2 * s], u[2 * s + 1]); \
            _Pragma("unroll") for (int mb = 0; mb < 4; ++mb) { S[mb] = S[mb] * glc; \
                S[mb] = MFMA16(AFR(3, mb, 0), Ub[0], S[mb]); S[mb] = MFMA16(AFR(3, mb, 1), Ub[1], S[mb]); } \
            _Pragma("unroll") for (int mb = 0; mb < 4; ++mb) { o[mb] = MFMA16(AFR(2, mb, 0), Ub[0], o[mb]); o[mb] = MFMA16(AFR(2, mb, 1), Ub[1], o[mb]); } \
            bf16_t* ob = obuf + (nq_ & 1) * 4608 + 16 * cgi + l15; \
            _Pragma("unroll") for (int mb = 0; mb < 4; ++mb) _Pragma("unroll") for (int r = 0; r < 4; ++r) ob[(16 * mb + 4 * gq + r) * 72] = (bf16_t)(pk2(o[mb][r], 0.f) & 0xffffu); \
            SCAN_BAR(); } while (0)
            for (int n = 0; n < SCAN_L; n += 4) { SCAN_STEP(W0, n); SCAN_STEP(W1, n + 1); SCAN_STEP(W2, n + 2); SCAN_STEP(W3, n + 3); }
#undef SCAN_STEP
        }
#undef AFR
#undef LDW
    }
}

DI void fox_attn_unit(const Params& P, int tid, int h, int qb, float PRUNE, int pir) {
    unsigned char* ws = P.ws;
    const int lane = tid & 63, wave = tid >> 6, r32 = lane & 31, hi = lane >> 5;
    const bf16_t* QN = (const bf16_t*)(ws + WS_PROJ) + 4 * BUF_ELEMS; const bf16_t* KN = (const bf16_t*)(ws + WS_PROJ) + 5 * BUF_ELEMS;
    const bf16_t* FZ = (const bf16_t*)(ws + WS_PROJ) + 7 * BUF_ELEMS; bf16_t* YB = (bf16_t*)(ws + WS_PROJ) + 1 * BUF_ELEMS;
    const bf16_t* VT = (const bf16_t*)(ws + WS_VT); const float* CL = (const float*)(ws + WS_CL); const float* CT = (const float*)(ws + WS_CT);
    (void)wave;
    const int t0 = qb * 32, nq = qb >> 1;
    const float* CLh = CL + (size_t)h * SEQ; const float* CTh = CT + h * 256;
    const bf16_t* KNh = KN + h * 64 + 8 * hi; const bf16_t* VTh = VT + (size_t)(h * 64 + r32) * SEQ + 8 * hi;
    bf16x8 qf[4];
#pragma unroll
    for (int ks = 0; ks < 4; ++ks) qf[ks] = *(const bf16x8*)(QN + (size_t)(t0 + r32) * 512 + h * 64 + 16 * ks + 8 * hi);
    const float cq = CLh[t0 + r32];
    const float cq0 = __uint_as_float(__builtin_amdgcn_readfirstlane(__float_as_uint(CLh[t0])));
    float offv; int nvalid;
    { const int cn = nq - 1 - lane; float pre = cn >= 0 ? CTh[cn] : 0.f;
#pragma unroll
      for (int o = 1; o < 64; o <<= 1) { const float up = __shfl_up(pre, o); if (lane >= o) pre += up; }
      const int kt = qb - 1 - lane, nk = kt >> 1, src = nq - 1 - nk;
      const float got = __shfl(pre, src < 0 ? 0 : src);
      offv = (kt >= 0 && src >= 0) ? got : 0.f;
      const float dmax = kt >= 0 ? cq0 + offv - CLh[32 * kt + 31] : -INFINITY;
      const unsigned long long stop = __ballot(dmax < -PRUNE || kt < 0);
      nvalid = stop ? (int)__builtin_ctzll(stop) : 64; }
    float mrun = -INFINITY, lsum = 0.f, offslow = 0.f;
    f32x16 oT[2];
#pragma unroll
    for (int i = 0; i < 16; ++i) { oT[0][i] = 0.f; oT[1][i] = 0.f; }
    bf16x8 kn_[4], vn_[2][2]; f32x4 cn_[4];
#define LOAD_TILE(k0_) do { const int kk0 = (k0_); \
        _Pragma("unroll") for (int ks = 0; ks < 4; ++ks) kn_[ks] = *(const bf16x8*)(KNh + (size_t)(kk0 + pir) * 512 + 16 * ks); \
        _Pragma("unroll") for (int blk = 0; blk < 2; ++blk) _Pragma("unroll") for (int s = 0; s < 2; ++s) vn_[blk][s] = *(const bf16x8*)(VTh + (size_t)(32 * blk) * SEQ + kk0 + 16 * s); \
        _Pragma("unroll") for (int s = 0; s < 2; ++s) { cn_[2 * s] = *(const f32x4*)(CLh + kk0 + 16 * s + 8 * hi); cn_[2 * s + 1] = *(const f32x4*)(CLh + kk0 + 16 * s + 8 * hi + 4); } } while (0)
    LOAD_TILE(t0);
    for (int kt = qb; kt >= 0; --kt) {
        float off = 0.f;
        if (kt != qb) {
            const int idx = qb - 1 - kt;
            if (idx < 64) { if (idx >= nvalid) break; off = __int_as_float(__builtin_amdgcn_readlane(__float_as_int(offv), idx)); offslow = off; }
            else {
                if (kt & 1) offslow += __uint_as_float(__builtin_amdgcn_readfirstlane(__float_as_uint(CTh[kt >> 1])));
                const float dmax = cq0 + offslow - __uint_as_float(__builtin_amdgcn_readfirstlane(__float_as_uint(CLh[32 * kt + 31])));
                if (dmax < -PRUNE) break;
                off = offslow; }
        }
        bf16x8 kf[4], vf[2][2]; f32x4 ck[4];
#pragma unroll
        for (int i = 0; i < 4; ++i) { kf[i] = kn_[i]; ck[i] = cn_[i]; }
        vf[0][0] = vn_[0][0]; vf[0][1] = vn_[0][1]; vf[1][0] = vn_[1][0]; vf[1][1] = vn_[1][1];
        if (kt > 0) LOAD_TILE(32 * (kt - 1));
        const float cb = cq + off;
        f32x16 sc;
#pragma unroll
        for (int i = 0; i < 16; ++i) sc[i] = cb;
#pragma unroll
        for (int ks = 0; ks < 4; ++ks) sc = MFMA32(kf[ks], qf[ks], sc);
        float mx = -INFINITY;
#pragma unroll
        for (int r = 0; r < 16; ++r) { const int kl = 16 * (r >> 3) + 8 * hi + (r & 7);
            float v = sc[r] - ck[r >> 2][r & 3];
            if (kt == qb && kl > r32) v = -INFINITY;
            sc[r] = v; mx = fmaxf(mx, v); }
        mx = fmaxf(mx, __shfl_xor(mx, 32));
        const float mnew = fmaxf(mrun, mx); const float alpha = __builtin_amdgcn_exp2f(mrun - mnew); mrun = mnew;
        float rs = 0.f;
#pragma unroll
        for (int r = 0; r < 16; ++r) { sc[r] = __builtin_amdgcn_exp2f(sc[r] - mnew); rs += sc[r]; }
        lsum = lsum * alpha + rs;
        if (__any(alpha != 1.0f)) {
#pragma unroll
            for (int i = 0; i < 16; ++i) { oT[0][i] *= alpha; oT[1][i] *= alpha; } }
        bf16x8 pb[2];
#pragma unroll
        for (int s = 0; s < 2; ++s) { u32x4 p; p.x = pk2(sc[8 * s], sc[8 * s + 1]); p.y = pk2(sc[8 * s + 2], sc[8 * s + 3]); p.z = pk2(sc[8 * s + 4], sc[8 * s + 5]); p.w = pk2(sc[8 * s + 6], sc[8 * s + 7]); pb[s] = __builtin_bit_cast(bf16x8, p); }
#pragma unroll
        for (int blk = 0; blk < 2; ++blk) { oT[blk] = MFMA32(vf[blk][0], pb[0], oT[blk]); oT[blk] = MFMA32(vf[blk][1], pb[1], oT[blk]); }
    }
#undef LOAD_TILE
    lsum += __shfl_xor(lsum, 32);
    const float inv = 1.0f / lsum;
    float ss = 0.f;
#pragma unroll
    for (int i = 0; i < 16; ++i) { oT[0][i] *= inv; oT[1][i] *= inv; ss += oT[0][i] * oT[0][i] + oT[1][i] * oT[1][i]; }
    ss += __shfl_xor(ss, 32);
    const float rstd = rsqrtf(ss * (1.f / 64.f) + EPS);
    const size_t rowoff = (size_t)(t0 + r32) * 512 + h * 64;
#pragma unroll
    for (int blk = 0; blk < 2; ++blk)
#pragma unroll
        for (int gi = 0; gi < 4; ++gi) { const int d = 32 * blk + 8 * gi + 4 * hi;
            const u32x2 z = *(const u32x2*)(FZ + rowoff + d); const f32x4 w = *(const f32x4*)(P.in[11] + d);
            const float z0 = bflo(z.x), z1 = bfhi(z.x), z2 = bflo(z.y), z3 = bfhi(z.y);
            u32x2 o; o.x = pk2(oT[blk][4 * gi] * rstd * w.x * z0 * sigmf(z0), oT[blk][4 * gi + 1] * rstd * w.y * z1 * sigmf(z1));
            o.y = pk2(oT[blk][4 * gi + 2] * rstd * w.z * z2 * sigmf(z2), oT[blk][4 * gi + 3] * rstd * w.w * z3 * sigmf(z3));
            *(u32x2*)(YB + rowoff + d) = o; }
}

#define BLK_BAR() asm volatile("s_waitcnt lgkmcnt(0)\n\ts_barrier" ::: "memory")
DI void fox_attn_blk(const Params& P, unsigned char* lds, LAS unsigned char* ldsl, int tid, int G, float PRUNE, int pir) {
    unsigned char* ws = P.ws;
    const int lane = tid & 63, wave = tid >> 6, r32 = lane & 31, hi = lane >> 5;
    const bf16_t* QN = (const bf16_t*)(ws + WS_PROJ) + 4 * BUF_ELEMS; const bf16_t* KN = (const bf16_t*)(ws + WS_PROJ) + 5 * BUF_ELEMS;
    const bf16_t* FZ = (const bf16_t*)(ws + WS_PROJ) + 7 * BUF_ELEMS; bf16_t* YB = (bf16_t*)(ws + WS_PROJ) + 1 * BUF_ELEMS;
    const bf16_t* VT = (const bf16_t*)(ws + WS_VT); const float* CL = (const float*)(ws + WS_CL); const float* CT = (const float*)(ws + WS_CT);
    const int h = (int)blockIdx.x & 7, bi = (int)blockIdx.x >> 3, nbh = G >> 3;
    const float* CLh = CL + (size_t)h * SEQ; const float* CTh = CT + h * 256;
    volatile int* nvs = (volatile int*)(lds + 12 * 10240);
    const int wvu = __builtin_amdgcn_readfirstlane(wave);
    const bool isk = tid < 256; const int sr = isk ? tid >> 3 : (tid - 256) >> 2, sl = isk ? tid & 7 : (tid - 256) & 3;
    const int scn = isk ? (sl ^ ((sr >> 1) & 7)) : (sl ^ ((sr >> 2) & 3));
    const bf16_t* gsrc = isk ? KN + (size_t)sr * 512 + h * 64 + 8 * scn : VT + (size_t)(h * 64 + sr) * SEQ + 8 * scn;
    const size_t gstep = isk ? (size_t)32 * 512 : (size_t)32;
    const int koff = pir * 128, ksw = (pir >> 1) & 7, voff = 4096 + r32 * 64, vsw = (r32 >> 2) & 3;
    for (int grp = bi; grp < 64; grp += nbh) {
        const int QB0 = grp * 8, qb = QB0 + wave, t0 = qb * 32, nq = qb >> 1;
        bf16x8 qf[4];
#pragma unroll
        for (int ks = 0; ks < 4; ++ks) qf[ks] = *(const bf16x8*)(QN + (size_t)(t0 + r32) * 512 + h * 64 + 16 * ks + 8 * hi);
        const float cq = CLh[t0 + r32];
        const float cq0 = __uint_as_float(__builtin_amdgcn_readfirstlane(__float_as_uint(CLh[t0])));
        float offv; int nvalid;
        { const int cn = nq - 1 - lane; float pre = cn >= 0 ? CTh[cn] : 0.f;
          const int kt = qb - 1 - lane; const float clen = kt >= 0 ? CLh[32 * kt + 31] : 0.f;
#pragma unroll
          for (int o = 1; o < 64; o <<= 1) { const float up = __shfl_up(pre, o); if (lane >= o) pre += up; }
          const int nk = kt >> 1, src = nq - 1 - nk;
          const float got = __shfl(pre, src < 0 ? 0 : src);
          offv = (kt >= 0 && src >= 0) ? got : 0.f;
          const float dmax = kt >= 0 ? cq0 + offv - clen : -INFINITY;
          const unsigned long long stop = __ballot(dmax < -PRUNE || kt < 0);
          nvalid = stop ? (int)__builtin_ctzll(stop) : 64; }
        const size_t rowoff = (size_t)(t0 + r32) * 512 + h * 64;
        if (lane == 0) nvs[wave] = nvalid;
        BLK_BAR();
        int nvmax = 0;
#pragma unroll
        for (int w_ = 0; w_ < 8; ++w_) { const int v_ = nvs[w_]; nvmax = v_ > nvmax ? v_ : nvmax; }
        nvmax = __builtin_amdgcn_readfirstlane(nvmax);
        if (nvmax >= 56) {
            BLK_BAR();
            fox_attn_unit(P, tid, h, qb, PRUNE, pir);
            continue; }
#define DMA_TILE(kt_) do { const int ku_ = (kt_), kc_ = ku_ > 0 ? ku_ : 0, b_ = (ku_ + 120) % 12; \
            __builtin_amdgcn_global_load_lds((const unsigned*)(gsrc + (size_t)kc_ * gstep), (LAS unsigned*)(ldsl + b_ * 10240 + wvu * 1024), 16, 0, 0); \
            __builtin_amdgcn_global_load_lds((const unsigned*)(CLh + 32 * kc_ + lane), (LAS unsigned*)(ldsl + b_ * 10240 + 8192 + wvu * 256), 4, 0, 0); } while (0)
        for (int j_ = 0; j_ < 11; ++j_) DMA_TILE(QB0 + 7 - j_);
        asm volatile("s_waitcnt vmcnt(6)" ::: "memory");
        float mrun = -INFINITY, lsum = 0.f;
        f32x16 oT[2];
#pragma unroll
        for (int i = 0; i < 16; ++i) { oT[0][i] = 0.f; oT[1][i] = 0.f; }
        BLK_BAR();
        const bool stag = wvu >= 4; bool pend = false;
        f32x16 sc; bf16x8 vf[2][2]; float alpha = 1.f;
#pragma unroll
        for (int i = 0; i < 16; ++i) sc[i] = 0.f;
        vf[0][0] = vf[0][1] = vf[1][0] = vf[1][1] = (bf16x8){0, 0, 0, 0, 0, 0, 0, 0};
#define ATT_TAIL() do { float rs = 0.f; \
            _Pragma("unroll") for (int r = 0; r < 16; ++r) rs += sc[r]; \
            lsum = lsum * alpha + rs; \
            if (__any(alpha != 1.0f)) { _Pragma("unroll") for (int i = 0; i < 16; ++i) { oT[0][i] *= alpha; oT[1][i] *= alpha; } } \
            bf16x8 pb[2]; \
            _Pragma("unroll") for (int s = 0; s < 2; ++s) { u32x4 p; p.x = pk2(sc[8 * s], sc[8 * s + 1]); p.y = pk2(sc[8 * s + 2], sc[8 * s + 3]); p.z = pk2(sc[8 * s + 4], sc[8 * s + 5]); p.w = pk2(sc[8 * s + 6], sc[8 * s + 7]); pb[s] = __builtin_bit_cast(bf16x8, p); } \
            _Pragma("unroll") for (int blk = 0; blk < 2; ++blk) { oT[blk] = MFMA32(vf[blk][0], pb[0], oT[blk]); oT[blk] = MFMA32(vf[blk][1], pb[1], oT[blk]); } } while (0)
        for (int it = 0; it <= nvmax; ++it) {
            if (pend) { ATT_TAIL(); pend = false; }
            DMA_TILE(QB0 - it - 4);
            const int kt = qb - it;
            if (it <= nvalid) {
                const unsigned char* tb = lds + ((kt + 120) % 12) * 10240;
                const float off = it == 0 ? 0.f : __int_as_float(__builtin_amdgcn_readlane(__float_as_int(offv), it - 1));
                bf16x8 kf[4]; f32x4 ck[4];
#pragma unroll
                for (int ks = 0; ks < 4; ++ks) kf[ks] = *(const bf16x8*)(tb + koff + (((2 * ks + hi) ^ ksw) << 4));
#pragma unroll
                for (int blk = 0; blk < 2; ++blk)
#pragma unroll
                    for (int s = 0; s < 2; ++s) vf[blk][s] = *(const bf16x8*)(tb + voff + blk * 2048 + (((2 * s + hi) ^ vsw) << 4));
#pragma unroll
                for (int s = 0; s < 2; ++s) { ck[2 * s] = *(const f32x4*)(tb + 8192 + wvu * 256 + (16 * s + 8 * hi) * 4); ck[2 * s + 1] = *(const f32x4*)(tb + 8192 + wvu * 256 + (16 * s + 8 * hi) * 4 + 16); }
                const float cb = cq + off;
#pragma unroll
                for (int i = 0; i < 16; ++i) sc[i] = cb;
#pragma unroll
                for (int ks = 0; ks < 4; ++ks) sc = MFMA32(kf[ks], qf[ks], sc);
                float mx = -INFINITY;
#pragma unroll
                for (int r = 0; r < 16; ++r) { const int kl = 16 * (r >> 3) + 8 * hi + (r & 7);
                    float v = sc[r] - ck[r >> 2][r & 3];
                    if (kt == qb && kl > r32) v = -INFINITY;
                    sc[r] = v; mx = fmaxf(mx, v); }
                { const auto rr = __builtin_amdgcn_permlane32_swap(__float_as_uint(mx), __float_as_uint(mx), false, false);
                  mx = fmaxf(__uint_as_float(rr[0]), __uint_as_float(rr[1])); }
                const float mnew = fmaxf(mrun, mx); alpha = __builtin_amdgcn_exp2f(mrun - mnew); mrun = mnew;
#pragma unroll
                for (int r = 0; r < 16; ++r) sc[r] = __builtin_amdgcn_exp2f(sc[r] - mnew);
                if (stag) pend = true; else ATT_TAIL();
            }
            asm volatile("s_waitcnt vmcnt(6)" ::: "memory");
            BLK_BAR();
        }
        if (pend) { ATT_TAIL(); pend = false; }
#undef ATT_TAIL
#undef DMA_TILE
        { const auto rr = __builtin_amdgcn_permlane32_swap(__float_as_uint(lsum), __float_as_uint(lsum), false, false); lsum = __uint_as_float(rr[0]) + __uint_as_float(rr[1]); }
        const float inv = 1.0f / lsum;
        float ss = 0.f;
#pragma unroll
        for (int i = 0; i < 16; ++i) { oT[0][i] *= inv; oT[1][i] *= inv; ss += oT[0][i] * oT[0][i] + oT[1][i] * oT[1][i]; }
        { const auto rr = __builtin_amdgcn_permlane32_swap(__float_as_uint(ss), __float_as_uint(ss), false, false); ss = __uint_as_float(rr[0]) + __uint_as_float(rr[1]); }
        const float rstd = rsqrtf(ss * (1.f / 64.f) + EPS);
#pragma unroll
        for (int blk = 0; blk < 2; ++blk)
#pragma unroll
            for (int gi = 0; gi < 4; ++gi) { const int d = 32 * blk + 8 * gi + 4 * hi;
                const u32x2 z = *(const u32x2*)(FZ + rowoff + d); const f32x4 w = *(const f32x4*)(P.in[11] + d);
                const float z0 = bflo(z.x), z1 = bfhi(z.x), z2 = bflo(z.y), z3 = bfhi(z.y);
                u32x2 o; o.x = pk2(oT[blk][4 * gi] * rstd * w.x * z0 * sigmf(z0), oT[blk][4 * gi + 1] * rstd * w.y * z1 * sigmf(z1));
                o.y = pk2(oT[blk][4 * gi + 2] * rstd * w.z * z2 * sigmf(z2), oT[blk][4 * gi + 3] * rstd * w.w * z3 * sigmf(z3));
                *(u32x2*)(YB + rowoff + d) = o; }
    }
}

DI void fox_attn(const Params& P, unsigned char* lds, LAS unsigned char* ldsl, int tid, int G) {
    const int lane = tid & 63, wave = tid >> 6, r32 = lane & 31;
    const float bq = wave_max(fabsf(P.in[9][lane])), bk = wave_max(fabsf(P.in[10][lane]));
    const float PRUNE = (2.f * 8.f * bq * bk + 30.f) * 1.4426950408889634f;
    const int pir = (r32 & ~12) | ((r32 & 4) << 1) | ((r32 & 8) >> 1);
    if ((G & 7) == 0) { fox_attn_blk(P, lds, ldsl, tid, G, PRUNE, pir); return; }
    const int nwaves = G * 8, gw = (int)blockIdx.x * 8 + wave;
    for (int u = gw; u < 4096; u += nwaves) fox_attn_unit(P, tid, u & 7, u >> 3, PRUNE, pir);
}

#define XB_TMO      128
#define XB_XCNT(j)  (256  + 64 * (j))
#define XB_XSUB(j)  (1280 + 64 * (j))
#define XB_XGEN(j)  (2304 + 64 * (j))
#define XB_TOP      3328
#define XB_TOPGEN   3392
#define XCD_BAR_WORDS 3456
#define XB_SPIN_CAP (1u << 18)
__device__ __forceinline__ unsigned xb_ld(unsigned* p)              { return __hip_atomic_load(p, __ATOMIC_RELAXED, __HIP_MEMORY_SCOPE_AGENT); }
__device__ __forceinline__ unsigned xb_add(unsigned* p, unsigned v) { return __hip_atomic_fetch_add(p, v, __ATOMIC_RELAXED, __HIP_MEMORY_SCOPE_AGENT); }
__device__ __forceinline__ unsigned xb_xcc_id() { return (unsigned)__builtin_amdgcn_s_getreg((3 << 11) | 20) & 0xFu; }
#define XB_SPIN(cond, bar) do { unsigned _sp = 0; while (cond) { __builtin_amdgcn_s_sleep(1); \
    if ((++_sp & 255u) == 0u) { if (xb_ld(&(bar)[XB_TMO])) break; if (_sp > XB_SPIN_CAP) { atomicAdd(&(bar)[XB_TMO], 1u); break; } } } } while (0)
struct XcdBarrier { unsigned* bar; unsigned x; volatile LAS unsigned* st; };
__device__ __forceinline__ XcdBarrier xcd_barrier_post(unsigned* bar, volatile LAS unsigned* st) {
    XcdBarrier b; b.bar = bar; b.x = xb_xcc_id(); b.st = st;
    if (threadIdx.x == 0) (void)xb_add(&bar[XB_XCNT(b.x)], 1u);
    return b;
}
__device__ __forceinline__ void xcd_barrier_complete(unsigned* bar, unsigned x, unsigned& nloc, unsigned& nx) {
    const unsigned G = gridDim.x * gridDim.y * gridDim.z;
    unsigned sum, cnt, mine, sp = 0u;
    for (;;) {
        sum = 0u; cnt = 0u; mine = 0u;
#pragma unroll
        for (unsigned j = 0; j < 16; ++j) { const unsigned c = xb_ld(&bar[XB_XCNT(j)]); sum += c; cnt += (c > 0u) ? 1u : 0u; mine = (j == x) ? c : mine; }
        if (sum == G) break;
        __builtin_amdgcn_s_sleep(1);
        if ((++sp & 255u) == 0u) { if (xb_ld(&bar[XB_TMO])) break; if (sp > XB_SPIN_CAP) { atomicAdd(&bar[XB_TMO], 1u); break; } }
    }
    nloc = mine > 0u ? mine : 1u; nx = cnt > 0u ? cnt : 1u;
}
__device__ __forceinline__ void xcd_barrier(const XcdBarrier& b) {
    asm volatile("s_waitcnt vmcnt(0)" ::: "memory");
    __syncthreads();
    if (threadIdx.x == 0) {
        unsigned* bar = b.bar;
        __builtin_amdgcn_s_waitcnt(0);
        unsigned nloc = b.st[0], nx = b.st[1];
        if (nloc == 0u) { xcd_barrier_complete(bar, b.x, nloc, nx); b.st[0] = nloc; b.st[1] = nx; }
        const unsigned old = xb_add(&bar[XB_XSUB(b.x)], 1u);
        const unsigned gen = old / nloc;
        if (old + 1u == (gen + 1u) * nloc) {
            __builtin_amdgcn_fence(__ATOMIC_RELEASE, "agent");
            asm volatile("s_waitcnt vmcnt(0)" ::: "memory");
            const unsigned og = xb_add(&bar[XB_TOP], 1u);
            const unsigned tg = og / nx;
            if (og + 1u == (tg + 1u) * nx) xb_add(&bar[XB_TOPGEN], 1u);
            else XB_SPIN(xb_ld(&bar[XB_TOPGEN]) == tg, bar);
            __builtin_amdgcn_fence(__ATOMIC_ACQUIRE, "agent");
            xb_add(&bar[XB_XGEN(b.x)], 1u);
            asm volatile("s_waitcnt vmcnt(0)" ::: "memory");
        } else {
            XB_SPIN(xb_ld(&bar[XB_XGEN(b.x)]) == gen, bar);
            __builtin_amdgcn_fence(__ATOMIC_ACQUIRE, "agent");
            asm volatile("s_waitcnt vmcnt(0)" ::: "memory");
        }
    }
    __syncthreads();
}

__global__ void __launch_bounds__(512, 2) mega_fwd(Params P) {
    extern __shared__ __attribute__((aligned(16))) unsigned char lds[];
    cg::grid_group grid = cg::this_grid();
    const int tid = threadIdx.x, G = gridDim.x;
    unsigned char* ws = P.ws;
    LAS unsigned char* ldsl = (LAS unsigned char*)lds;
    volatile LAS unsigned* bst = (volatile LAS unsigned*)(ldsl + 151040);
    if (tid < 2) bst[tid] = 0u;
    __syncthreads();
    const XcdBarrier bar = xcd_barrier_post((unsigned*)(ws + WS_BAR), bst);

    phase0(P, lds, tid, G);
    if ((G & 7) == 0) xcd_barrier(bar); else grid.sync();

    { pg8::Gemm g{(const bf16_t*)(ws + WS_H), (const bf16_t*)(ws + WS_WIN), SEQ, NMAIN, 1024}; pg8::StaticOrder S; S.init(SEQ, NMAIN, G, (int)blockIdx.x);
      pg8::EpiSplitBf16 E{(bf16_t*)(ws + WS_PROJ), BUF_ELEMS};
      pg8::gemm_phase<pg8::EpiSplitBf16, pg8::StaticOrder, true, true>(ldsl, g, S, E);
      small_proj(P, lds, tid, G);
 }
    if ((G & 7) == 0) xcd_barrier(bar); else grid.sync();

    if (G == 256) {
      const int hb = (int)blockIdx.x & 7, gb = (int)blockIdx.x >> 3;
      { u32x4 raw[12]; float sbv = 0.f, sav = 0.f;
        gdn_load(P, (8 * gb) * 8 + hb, tid, raw, sbv, sav);
        for (int i = tid; i < 768; i += 512) { const int j = i / 192, r = i % 192; ((float*)(lds + 86016))[i] = P.in[4][j * 1536 + (r >> 6) * 512 + hb * 64 + (r & 63)]; }
        __syncthreads();
        for (int k = 0; k < 8; ++k) gdn_prep_unit(P, hb, 8 * gb + k, lds, tid, raw, sbv, sav, k < 7 ? (8 * gb + k + 1) * 8 + hb : -1, true); }
      __syncthreads();
      gdn_scan<true>(P, hb, gb, lds, ldsl, tid);
      __syncthreads();
      for (int n = blockIdx.x; n < 256; n += G) fox_prep_unit(P, n, lds, tid);
      if ((G & 7) == 0) xcd_barrier(bar); else grid.sync();
    } else {
      { u32x4 raw[12]; float sbv = 0.f, sav = 0.f;
        if ((int)blockIdx.x < 2048) gdn_load(P, (int)blockIdx.x, tid, raw, sbv, sav);
        for (int u = blockIdx.x; u < 2048; u += G) gdn_prep_unit(P, u & 7, u >> 3, lds, tid, raw, sbv, sav, u + G < 2048 ? u + G : -1);
        __syncthreads(); }
      for (int n = blockIdx.x; n < 256; n += G) fox_prep_unit(P, n, lds, tid);
      if ((G & 7) == 0) xcd_barrier(bar); else grid.sync();
      for (int u = blockIdx.x; u < 256; u += G) { gdn_scan<true>(P, u & 7, u >> 3, lds, ldsl, tid); __syncthreads(); }
      if ((G & 7) == 0) xcd_barrier(bar); else grid.sync();
    }
    for (int u = blockIdx.x; u < 256; u += G) { gdn_scan<false>(P, u & 7, u >> 3, lds, ldsl, tid); __syncthreads(); }
    fox_attn(P, lds, ldsl, tid, G);
    if ((G & 7) == 0) xcd_barrier(bar); else grid.sync();

    { pg8::StaticOrder S; S.init(SEQ, 1024, G, (int)blockIdx.x);
      bf16_t* Mo = (bf16_t*)(ws + WS_PROJ) + 2 * BUF_ELEMS;
      { pg8::Gemm g{(const bf16_t*)(ws + WS_PROJ), (const bf16_t*)(ws + WS_WUPA), SEQ, 1024, 512};
        pg8::EpiGate E{Mo, (const bf16_t*)(ws + WS_PROJ) + 8 * BUF_ELEMS, BUF_ELEMS, P.in[3], 0};
        pg8::gemm_phase<pg8::EpiGate, pg8::StaticOrder, true, true>(ldsl, g, S, E); }
      __syncthreads();
      { pg8::Gemm g{(const bf16_t*)(ws + WS_PROJ) + BUF_ELEMS, (const bf16_t*)(ws + WS_WUPB), SEQ, 1024, 512};
        pg8::EpiGate E{Mo, (const bf16_t*)(ws + WS_PROJ) + 10 * BUF_ELEMS, BUF_ELEMS, P.in[3] + 1024, 1};
        pg8::gemm_phase<pg8::EpiGate, pg8::StaticOrder, true, true>(ldsl, g, S, E); } }
    if ((G & 7) == 0) xcd_barrier(bar); else grid.sync();

    if (G == 256) {
      pg8::StaticOrder S; S.init(SEQ, 1024, G, (int)blockIdx.x);
      pg8::Gemm g{(const bf16_t*)(ws + WS_PROJ) + 2 * BUF_ELEMS, (const bf16_t*)(ws + WS_WOUT), SEQ, 1024, 1024};
      pg8::EpiResNorm E{P.in[0], P.out, P.in[15], (float*)(ws + WS_XB), (unsigned*)(ws + WS_PCNT), EPS};
      pg8::gemm_phase<pg8::EpiResNorm, pg8::StaticOrder, false, true>(ldsl, g, S, E);
    } else {
      { pg8::StaticOrder S; S.init(SEQ, 1024, G, (int)blockIdx.x);
        pg8::Gemm g{(const bf16_t*)(ws + WS_PROJ) + 2 * BUF_ELEMS, (const bf16_t*)(ws + WS_WOUT), SEQ, 1024, 1024};
        pg8::EpiRes E{P.in[0], P.out};
        pg8::gemm_phase<pg8::EpiRes, pg8::StaticOrder, true, true>(ldsl, g, S, E); }
      if ((G & 7) == 0) xcd_barrier(bar); else grid.sync();
      { const int lane = tid & 63, wave = tid >> 6, gw = blockIdx.x * 8 + wave, NGW = G * 8;
        const float* fw = P.in[15]; f32x4 wv[4];
#pragma unroll
        for (int j = 0; j < 4; ++j) wv[j] = *(const f32x4*)(fw + 4 * lane + 256 * j);
        for (int m = gw; m < SEQ; m += NGW) {
            f32x4* xr = (f32x4*)(P.out + (size_t)m * DM) + lane; f32x4 v[4]; float s = 0.f;
#pragma unroll
            for (int j = 0; j < 4; ++j) { v[j] = xr[64 * j]; s += (v[j].x * v[j].x + v[j].y * v[j].y) + (v[j].z * v[j].z + v[j].w * v[j].w); }
            const float rstd = rsqrtf(wave_sum(s) * (1.f / DM) + EPS);
#pragma unroll
            for (int j = 0; j < 4; ++j) xr[64 * j] = v[j] * rstd * wv[j];
        } }
    }
}

extern "C" void kernel_launch(void* const* d_in, const int* in_sizes, int n_in, void* d_out, int out_size, void* d_ws, size_t ws_size, hipStream_t stream) {
    static int grid = 0;
    if (grid == 0) {
        if (n_in != 16 || out_size != SEQ * DM || ws_size < WS_END) { fprintf(stderr, "kernel_launch: unexpected shapes (n_in %d out %d ws %zu)\n", n_in, out_size, ws_size); grid = -1; return; }
        int dev = 0, cus = 0, per_cu = 0;
        hipGetDevice(&dev); hipDeviceGetAttribute(&cus, hipDeviceAttributeMultiprocessorCount, dev);
        if (hipFuncSetAttribute((const void*)mega_fwd, hipFuncAttributeMaxDynamicSharedMemorySize, LDS_BYTES) != hipSuccess) { fprintf(stderr, "hipFuncSetAttribute failed\n"); grid = -1; return; }
        if (hipOccupancyMaxActiveBlocksPerMultiprocessor(&per_cu, (const void*)mega_fwd, 512, LDS_BYTES) != hipSuccess || per_cu < 1) { fprintf(stderr, "occupancy query failed (%d)\n", per_cu); grid = -1; return; }
        grid = cus;
        if (grid < 16) { grid = -1; return; }
    }
    if (grid < 0) return;
    if (hipMemsetAsync((char*)d_ws + WS_BAR, 0, 32768, stream) != hipSuccess) { fprintf(stderr, "memset failed\n"); return; }
    Params p{};
    for (int i = 0; i < 16; ++i) p.in[i] = (const float*)d_in[i];
    p.out = (float*)d_out; p.ws = (unsigned char*)d_ws;
    void* args[] = {&p};
    hipError_t e = hipLaunchCooperativeKernel((const void*)mega_fwd, dim3(grid), dim3(512), args, LDS_BYTES, stream);
    if (e != hipSuccess) fprintf(stderr, "cooperative launch failed: %s (grid %d)\n", hipGetErrorString(e), grid);
}
```
